# Optimizing an MI355X kernel written in HIP

```python
import jax, jax.numpy as jnp
from jax import lax
import numpy as np

D_MODEL = 2048
BATCH = 4
SEQ = 4096
DEPTH = 1

CHUNK = 64
A_HEADS = 16
A_HEAD_DIM = 64
A_WIDTH = A_HEADS * A_HEAD_DIM
A_PAST_CHUNKS = 8
A_BAND = (A_PAST_CHUNKS + 1) * CHUNK
REL_CLIP = 256
REL_SIZE = REL_CLIP + CHUNK
B_HEADS = 4
B_KEY_DIM = D_MODEL // 4
B_VAL_DIM = D_MODEL // 2
B_HK = B_KEY_DIM // B_HEADS
B_HV = B_VAL_DIM // B_HEADS
GATE_RANK = 16
GATE_TAU = 16.0
D_FF = 256 * ((8 * D_MODEL // 3 + 255) // 256)
N_MOD = 9
ALPHA = (2.0 * DEPTH) ** 0.25
BETA = (8.0 * DEPTH) ** -0.25
LN_EPS = 1e-5
RMS_EPS = 1e-6
SPLITS = (A_WIDTH, A_WIDTH, A_WIDTH,
          B_KEY_DIM, B_KEY_DIM, B_VAL_DIM,
          B_VAL_DIM, GATE_RANK,
          D_MODEL, D_MODEL)
SPLIT_POINTS = tuple(int(v) for v in np.cumsum(SPLITS)[:-1])
W_IN_COLS = sum(SPLITS)

kernel_name = "hybrid_chunk_attn_gla_macaron_deepnorm_adaln"


def layer_norm(x, g, b):
    xf = x.astype(jnp.float32)
    mu = jnp.mean(xf, axis=-1, keepdims=True)
    var = jnp.mean(jnp.square(xf - mu), axis=-1, keepdims=True)
    y = (xf - mu) * lax.rsqrt(var + LN_EPS)
    return (y * g.astype(jnp.float32) + b.astype(jnp.float32)).astype(x.dtype)


def modulate(x, shift, scale):
    return x * (1.0 + scale[:, None, :]) + shift[:, None, :]


def swiglu(u, w_in, w_out):
    a, b = jnp.split(u @ w_in, 2, axis=-1)
    return (jax.nn.silu(a) * b) @ w_out


def chunk_band_attention(q, k, v, rel_bias):
    bn, s, h, dh = q.shape
    nc = s // CHUNK
    pad = A_PAST_CHUNKS * CHUNK
    kp = jnp.pad(k, ((0, 0), (pad, 0), (0, 0), (0, 0)))
    vp = jnp.pad(v, ((0, 0), (pad, 0), (0, 0), (0, 0)))
    qi = jnp.arange(CHUNK)[:, None]
    ks = jnp.arange(A_BAND)[None, :]
    rel = ks - pad - qi
    idx = jnp.clip(rel, -REL_CLIP, CHUNK - 1) + REL_CLIP
    bias = rel_bias[:, idx].astype(jnp.float32)
    qc = q.reshape(bn, nc, CHUNK, h, dh).swapaxes(0, 1)
    scale = dh ** -0.5

    def one_chunk(args):
        n, qn = args
        start = n * CHUNK
        kb = lax.dynamic_slice_in_dim(kp, start, A_BAND, axis=1)
        vb = lax.dynamic_slice_in_dim(vp, start, A_BAND, axis=1)
        sc = jnp.einsum('bqhd,bkhd->bhqk', qn, kb).astype(jnp.float32) * scale + bias
        valid = (start - pad + jnp.arange(A_BAND)) >= 0
        sc = jnp.where(valid, sc, -jnp.inf)
        p = jax.nn.softmax(sc, axis=-1).astype(vb.dtype)
        return jnp.einsum('bhqk,bkhd->bqhd', p, vb)

    out = lax.map(one_chunk, (jnp.arange(nc), qc))
    return out.swapaxes(0, 1).reshape(bn, s, h * dh)


def gla_chunk_readout(q, k, v, log_a):
    bn, s, h, dk = q.shape
    dv = v.shape[-1]
    nc = s // CHUNK
    qc = q.reshape(bn, nc, CHUNK, h, dk).astype(jnp.float32)
    kc = k.reshape(bn, nc, CHUNK, h, dk).astype(jnp.float32)
    vc = v.reshape(bn, nc, CHUNK, h, dv).astype(jnp.float32)
    cum = jnp.cumsum(log_a.reshape(bn, nc, CHUNK, h, dk).astype(jnp.float32), axis=2)
    last = cum[:, :, -1:]
    kdec = kc * jnp.exp(last - cum)
    u = jnp.einsum('bnchk,bnchv->bnhkv', kdec, vc)
    chunk_decay = jnp.exp(last[:, :, 0])

    def step(state, xs):
        dec, un, qn = xs
        state = dec[..., None] * state + un
        return state, jnp.einsum('bchk,bhkv->bchv', qn, state)

    s0 = jnp.zeros((bn, h, dk, dv), jnp.float32)
    _, o = lax.scan(step, s0, (chunk_decay.swapaxes(0, 1), u.swapaxes(0, 1), qc.swapaxes(0, 1)))
    return o.swapaxes(0, 1).reshape(bn, s, h, dv)


def token_mix(u, w_mix_in, rel_bias, w_alpha2, b_alpha, gla_norm_g, w_proj_a, w_proj_b, w_mix_out):
    bn, s, _ = u.shape
    qa, ka, va, qb, kb, vb, rb, lr, ga, gb = jnp.split(u @ w_mix_in, SPLIT_POINTS, axis=-1)
    ya = chunk_band_attention(qa.reshape(bn, s, A_HEADS, A_HEAD_DIM),
                              ka.reshape(bn, s, A_HEADS, A_HEAD_DIM),
                              va.reshape(bn, s, A_HEADS, A_HEAD_DIM), rel_bias)
    log_a = jax.nn.log_sigmoid((lr @ w_alpha2 + b_alpha).astype(jnp.float32)) / GATE_TAU
    ob = gla_chunk_readout(qb.reshape(bn, s, B_HEADS, B_HK) * (B_HK ** -0.5),
                           kb.reshape(bn, s, B_HEADS, B_HK),
                           vb.reshape(bn, s, B_HEADS, B_HV),
                           log_a.reshape(bn, s, B_HEADS, B_HK))
    ob = ob * lax.rsqrt(jnp.mean(jnp.square(ob), axis=-1, keepdims=True) + RMS_EPS)
    ob = (ob * gla_norm_g.astype(jnp.float32)).astype(u.dtype).reshape(bn, s, B_VAL_DIM)
    yb = ob * jax.nn.silu(rb)
    merged = jax.nn.sigmoid(ga) * (ya @ w_proj_a) + jax.nn.sigmoid(gb) * (yb @ w_proj_b)
    return merged @ w_mix_out


def setup_inputs(seed: int = 0) -> dict:
    key = jax.random.key(seed)
    ks = jax.random.split(key, 24)
    f32 = jnp.float32
    nrm = lambda k, shape, s: jax.random.normal(k, shape, f32) * s
    L, D = DEPTH, D_MODEL
    return {
        "x": nrm(ks[0], (BATCH, SEQ, D), 1.0),
        "c": nrm(ks[1], (BATCH, D), 1.0),
        "w_ada": nrm(ks[2], (L, D, N_MOD * D), 0.5 * D ** -0.5),
        "b_ada": nrm(ks[3], (L, N_MOD * D), 0.01),
        "ffn1_w_in": nrm(ks[4], (L, D, 2 * D_FF), D ** -0.5),
        "ffn1_w_out": nrm(ks[5], (L, D_FF, D), BETA * D_FF ** -0.5),
        "ln1_g": 1.0 + nrm(ks[6], (L, D), 0.02),
        "ln1_b": nrm(ks[7], (L, D), 0.02),
        "w_mix_in": nrm(ks[8], (L, D, W_IN_COLS), D ** -0.5),
        "rel_bias": nrm(ks[9], (L, A_HEADS, REL_SIZE), 0.5),
        "w_alpha2": nrm(ks[10], (L, GATE_RANK, B_KEY_DIM), GATE_RANK ** -0.5),
        "b_alpha": nrm(ks[11], (L, B_KEY_DIM), 0.1),
        "gla_norm_g": 1.0 + nrm(ks[12], (L, B_HV), 0.02),
        "w_proj_a": nrm(ks[13], (L, A_WIDTH, D), BETA * A_WIDTH ** -0.5),
        "w_proj_b": nrm(ks[14], (L, B_VAL_DIM, D), BETA * B_VAL_DIM ** -0.5),
        "w_mix_out": nrm(ks[15], (L, D, D), BETA * D ** -0.5),
        "ln2_g": 1.0 + nrm(ks[16], (L, D), 0.02),
        "ln2_b": nrm(ks[17], (L, D), 0.02),
        "ffn2_w_in": nrm(ks[18], (L, D, 2 * D_FF), D ** -0.5),
        "ffn2_w_out": nrm(ks[19], (L, D_FF, D), BETA * D_FF ** -0.5),
        "ln3_g": 1.0 + nrm(ks[20], (L, D), 0.02),
        "ln3_b": nrm(ks[21], (L, D), 0.02),
    }


def reference(x, c, w_ada, b_ada, ffn1_w_in, ffn1_w_out, ln1_g, ln1_b, w_mix_in, rel_bias,
              w_alpha2, b_alpha, gla_norm_g, w_proj_a, w_proj_b, w_mix_out, ln2_g, ln2_b,
              ffn2_w_in, ffn2_w_out, ln3_g, ln3_b):
    h = x
    for l in range(DEPTH):
        mod = jax.nn.silu(c) @ w_ada[l] + b_ada[l]
        sh1, sc1, g1, sh2, sc2, g2, sh3, sc3, g3 = jnp.split(mod, N_MOD, axis=-1)
        f1 = swiglu(modulate(h, sh1, sc1), ffn1_w_in[l], ffn1_w_out[l])
        h = layer_norm(ALPHA * h + 0.5 * g1[:, None, :] * f1, ln1_g[l], ln1_b[l])
        m = token_mix(modulate(h, sh2, sc2), w_mix_in[l], rel_bias[l], w_alpha2[l], b_alpha[l],
                      gla_norm_g[l], w_proj_a[l], w_proj_b[l], w_mix_out[l])
        h = layer_norm(ALPHA * h + g2[:, None, :] * m, ln2_g[l], ln2_b[l])
        f2 = swiglu(modulate(h, sh3, sc3), ffn2_w_in[l], ffn2_w_out[l])
        h = layer_norm(ALPHA * h + 0.5 * g3[:, None, :] * f2, ln3_g[l], ln3_b[l])
    return h
```

```cpp
#include <hip/hip_runtime.h>
#include <hip/hip_cooperative_groups.h>
#include <cstdio>
#include <cstdint>
namespace cg = cooperative_groups;

#ifndef MK_COOP
#define MK_COOP 1
#endif

#ifndef ALIGN2
#define ALIGN2 false
#endif
#ifndef PROBE_DUP
#define PROBE_DUP 0
#endif

#define LAS __attribute__((address_space(3)))
typedef unsigned short bf16_t;
typedef short bf16x8 __attribute__((ext_vector_type(8)));
typedef float f32x4 __attribute__((ext_vector_type(4)));
typedef float f32x16 __attribute__((ext_vector_type(16)));
typedef unsigned u32x4 __attribute__((ext_vector_type(4)));
typedef unsigned u32x2 __attribute__((ext_vector_type(2)));
typedef short s16x4 __attribute__((ext_vector_type(4)));
typedef int i32x4 __attribute__((ext_vector_type(4)));
typedef int i32x8 __attribute__((ext_vector_type(8)));
constexpr int FIN_BF_TILES = 36;
constexpr float G8_SCALE = 64.f;

constexpr int M_TOK = 16384, DM = 2048, DFF = 5632, SEQ = 4096, NMOD = 18432;
constexpr int MIXP = 6144;
constexpr int GP = 4096;
constexpr int C_QA = 0, C_KA = 1024, C_VA = 2048, C_QB = 3072, C_KB = 3584, C_VB = 4096, C_RB = 5120, C_MERGED = 1024;
constexpr int WMIX_SRC_LD = 10256;
constexpr float ALPHA = 1.189207115002721f;
constexpr float LN_EPS = 1e-5f, RMS_EPS = 1e-6f;
constexpr float LOG2E = 1.4426950408889634f;

constexpr size_t MiB = 1u << 20;
constexpr size_t WS_BAR = 320 * 1024, BAR_BYTES = 16384;
constexpr size_t WS_STAT = 336 * 1024;
constexpr size_t WS_MOD = 4096;
constexpr size_t WS_DEC = 512 * 1024;
constexpr size_t WS_W1IN = 1 * MiB, WS_W1OUT = 45 * MiB, WS_WMIX = 67 * MiB, WS_WLR = 107 * MiB, WS_WPA = 108 * MiB, WS_WPB = 112 * MiB,
                 WS_WMO = 116 * MiB, WS_W2IN = 124 * MiB, WS_W2OUT = 168 * MiB, WS_U = 190 * MiB, WS_H = 254 * MiB, WS_BIG = 382 * MiB, WS_UB = 574 * MiB, WS_W1IN8 = 638 * MiB, WS_W2IN8 = 642 * MiB, WS_END = 646 * MiB;

constexpr size_t WS_WG8 = 91 * MiB;
constexpr int LDS_MISC = 147456 - 64;
constexpr int LDS_BYTES = 147456;

typedef float f32x2_t __attribute__((ext_vector_type(2))); typedef __bf16 bf16x2_t __attribute__((ext_vector_type(2)));
__device__ __forceinline__ unsigned cvt_pk_bf16(float lo, float hi) { const f32x2_t v = {lo, hi}; const bf16x2_t b = __builtin_convertvector(v, bf16x2_t); return __builtin_bit_cast(unsigned, b); }
__device__ __forceinline__ float bf_lo(unsigned w) { return __uint_as_float(w << 16); }
__device__ __forceinline__ float bf_hi(unsigned w) { return __uint_as_float(w & 0xffff0000u); }
__device__ __forceinline__ float fast_sigmoid(float x) { return __builtin_amdgcn_rcpf(1.f + __builtin_amdgcn_exp2f(-LOG2E * x)); }
__device__ __forceinline__ float fast_silu(float x) { return x * fast_sigmoid(x); }
__device__ __forceinline__ f32x2_t sigmoid_pk(f32x2_t x) { const f32x2_t t = x * (-LOG2E); f32x2_t e; e[0] = __builtin_amdgcn_exp2f(t[0]); e[1] = __builtin_amdgcn_exp2f(t[1]);
    const f32x2_t d = e + 1.0f; f32x2_t r; r[0] = __builtin_amdgcn_rcpf(d[0]); r[1] = __builtin_amdgcn_rcpf(d[1]); return r; }
template <bool F8> __device__ __forceinline__ f32x2_t sigmoid_sc_pk(f32x2_t x) { constexpr float k = F8 ? -LOG2E / 64.f : -LOG2E; const f32x2_t t = x * k; f32x2_t e; e[0] = __builtin_amdgcn_exp2f(t[0]); e[1] = __builtin_amdgcn_exp2f(t[1]);
    const f32x2_t d = e + 1.0f; f32x2_t r; r[0] = __builtin_amdgcn_rcpf(d[0]); r[1] = __builtin_amdgcn_rcpf(d[1]); return r; }
template <bool F8> __device__ __forceinline__ f32x4 swiglu_pk4(f32x4 a, f32x4 b) { const f32x2_t a0 = {a[0], a[1]}, a1 = {a[2], a[3]}, b0 = {b[0], b[1]}, b1 = {b[2], b[3]};
    constexpr float s2 = F8 ? 1.f / (64.f * 64.f) : 1.f;
    f32x2_t o0 = (a0 * b0) * sigmoid_sc_pk<F8>(a0), o1 = (a1 * b1) * sigmoid_sc_pk<F8>(a1); if constexpr (F8) { o0 = o0 * s2; o1 = o1 * s2; } return (f32x4){o0[0], o0[1], o1[0], o1[1]}; }
__device__ __forceinline__ f32x4 gate_pk4(f32x4 v, unsigned glo, unsigned ghi) {
    const f32x2_t g0 = {__uint_as_float(glo << 16), __uint_as_float(glo & 0xffff0000u)}, g1 = {__uint_as_float(ghi << 16), __uint_as_float(ghi & 0xffff0000u)};
    const f32x2_t v0 = {v[0], v[1]}, v1 = {v[2], v[3]}; const f32x2_t o0 = v0 * sigmoid_pk(g0), o1 = v1 * sigmoid_pk(g1); return (f32x4){o0[0], o0[1], o1[0], o1[1]}; }
__device__ __forceinline__ float wave_sum(float v) {
#pragma unroll
    for (int o = 1; o < 64; o <<= 1) v += __shfl_xor(v, o);
    return v;
}

namespace pg8 {
constexpr int BM = 256, BK = 64, HALF = 128, HTB = HALF * BK * 2, STAGE_BYTES = 8 * HTB, NXCD = 8, WGM = 8;
__host__ __device__ __forceinline__ int lds_byte(int r, int c) { const int st = (r >> 4) * 2 + (c >> 5), rr = r & 15, cc = c & 31, ob = rr * 64 + cc * 2; return st * 1024 + (ob ^ (((ob >> 9) & 1) << 5)); }
__host__ __device__ __forceinline__ void stage_rc(int b, int& R, int& C) { const int st = b / 1024, sb = b % 1024, swz = sb ^ (((sb >> 9) & 1) << 5); R = (st >> 1) * 16 + swz / 64; C = (st & 1) * 32 + (swz % 64) / 2; }
__host__ __device__ __forceinline__ int perm32(int rho) { const int n = rho >> 4, i = rho & 15; return 8 * (i >> 2) + 4 * n + (i & 3); }

struct Unit { int pm, pn; };
struct Gemm { const bf16_t* A; const bf16_t* Bt; int M, N, K, lda; };

struct StaticOrder {
    int nM, nN, nwg, G, c;
    __host__ __device__ void init(int M, int N, int G_, int c_) { nM = M / BM; nN = N / BM; nwg = nM * nN; G = G_; c = c_; }
    __host__ __device__ bool next(int i, Unit& u) const {
        const long L = (long)i * G + c; if (L >= nwg) return false;
        int wgid = (int)L; { const int q = nwg / NXCD, r = nwg % NXCD, xcd = wgid % NXCD, off = wgid / NXCD; wgid = (xcd < r ? xcd * (q + 1) : r * (q + 1) + (xcd - r) * q) + off; }
        const int nig = WGM * nN, gid = wgid / nig, fm = gid * WGM, gsz = (nM - fm) < WGM ? (nM - fm) : WGM;
        u.pm = fm + ((wgid % nig) % gsz); u.pn = (wgid % nig) / gsz; return true;
    }
};

template <class Epi, class Sched, bool ALIGN_EPI, bool FP8 = false>
__device__ __forceinline__ void gemm_phase(LAS unsigned char* lds, const Gemm g, const Sched& S, const Epi& E) {
    int tid_ = threadIdx.x; asm volatile("" : "+v"(tid_));
    const int tid = tid_, wid = __builtin_amdgcn_readfirstlane(tid >> 6), lane = tid & 63, wr = wid >> 2, wc = wid & 3, fr = lane & 15, fq = lane >> 4;
    const int K = g.K, nt = FP8 ? K / 128 : K / BK, lda = g.lda;
    const int pitchA = FP8 ? lda : lda * 2, pitchB = FP8 ? K : K * 2;
    unsigned voffA[2], voffB[2];
#pragma unroll
    for (int i = 0; i < 2; ++i) { int R, C; stage_rc(tid * 16 + i * 8192, R, C); const int Rb = Epi::PERM ? ((R & ~31) + perm32(R & 31)) : R;
        voffA[i] = (unsigned)(R * pitchA + C * 2); voffB[i] = (unsigned)(Rb * pitchB + C * 2); }
    const size_t kstep = (size_t)(BK * 2);
    const size_t hstepA = (size_t)HALF * pitchA, hstepB = (size_t)HALF * pitchB;
    const size_t tstepA = 2 * hstepA, tstepB = 2 * hstepB;
    const unsigned ldsw = (unsigned)wid * 1024u;
    const int aoff = lds_byte(wr * 64 + fr, fq * 8), boff = lds_byte(wc * 32 + fr, fq * 8);
#define PG8_SA(b, h) (((b) * 2 + (h)) * HTB)
#define PG8_SB(b, h) ((4 + (b) * 2 + (h)) * HTB)
#define PG8_STAGE(bufoff, gbase, voff) do { _Pragma("unroll") for (int _i = 0; _i < 2; ++_i) \
        __builtin_amdgcn_global_load_lds((const unsigned*)((const char*)(gbase) + (voff)[_i]), (LAS unsigned*)(lds + (bufoff) + ldsw + _i * 8192), 16, 0, 0); } while (0)
#define PG8_LD8(off) __builtin_shufflevector(*(const LAS i32x4*)(lds + (off)), *(const LAS i32x4*)(lds + (off) + 1024), 0, 1, 2, 3, 4, 5, 6, 7)
#define PG8_LDA(dst, b, h) do { if constexpr (FP8) { _Pragma("unroll") for (int m = 0; m < 4; ++m) dst##8[m] = PG8_LD8(PG8_SA(b, h) + aoff + m * 2048); } \
        else { _Pragma("unroll") for (int m = 0; m < 4; ++m) _Pragma("unroll") for (int k = 0; k < 2; ++k) dst[m][k] = *(const LAS bf16x8*)(lds + PG8_SA(b, h) + aoff + m * 2048 + k * 1024); } } while (0)
#define PG8_LDB(dst, b, h) do { if constexpr (FP8) { _Pragma("unroll") for (int n = 0; n < 2; ++n) dst##8[n] = PG8_LD8(PG8_SB(b, h) + boff + n * 2048); } \
        else { _Pragma("unroll") for (int n = 0; n < 2; ++n) _Pragma("unroll") for (int k = 0; k < 2; ++k) dst[n][k] = *(const LAS bf16x8*)(lds + PG8_SB(b, h) + boff + n * 2048 + k * 1024); } } while (0)
#define PG8_CAT8(x) __builtin_shufflevector(__builtin_bit_cast(i32x4, (x)[0]), __builtin_bit_cast(i32x4, (x)[1]), 0, 1, 2, 3, 4, 5, 6, 7)
#define PG8_MMA(ai, bj, At, Bt) do { __builtin_amdgcn_s_setprio(1); \
        if constexpr (FP8) { _Pragma("unroll") for (int m = 0; m < 4; ++m) _Pragma("unroll") for (int n = 0; n < 2; ++n) \
            asm volatile("v_mfma_f32_16x16x128_f8f6f4 %0, %1, %2, %0" : "+v"(acc[ai][bj][m][n]) : "v"(Bt##8[n]), "v"(At##8[m])); } \
        else { _Pragma("unroll") for (int m = 0; m < 4; ++m) _Pragma("unroll") for (int n = 0; n < 2; ++n) _Pragma("unroll") for (int k = 0; k < 2; ++k) \
            acc[ai][bj][m][n] = __builtin_amdgcn_mfma_f32_16x16x32_bf16(Bt[n][k], At[m][k], acc[ai][bj][m][n], 0, 0, 0); } \
        __builtin_amdgcn_s_setprio(0); } while (0)
#define PG8_WAIT_V(n) asm volatile("s_waitcnt vmcnt(" #n ")" ::: "memory")
#define PG8_WAIT_L(n) asm volatile("s_waitcnt lgkmcnt(" #n ")" ::: "memory")
#define PG8_BAR __builtin_amdgcn_s_barrier()
#define PG8_SCHED __builtin_amdgcn_sched_barrier(0)
    Unit cur, nxt; int ui = 0;
    if (!S.next(0, cur)) return;
    f32x4 acc[2][2][4][2];
#pragma unroll
    for (int a = 0; a < 2; ++a)
#pragma unroll
        for (int b = 0; b < 2; ++b)
#pragma unroll
            for (int m = 0; m < 4; ++m)
#pragma unroll
                for (int n = 0; n < 2; ++n) acc[a][b][m][n] = (f32x4){0.f, 0.f, 0.f, 0.f};
    bf16x8 At[4][2], B0[2][2], B1[2][2];
    i32x8 At8[4], B08[2], B18[2];
    const char* cA = (const char*)g.A + (size_t)cur.pm * tstepA; const char* cB = (const char*)g.Bt + (size_t)cur.pn * tstepB;
    PG8_STAGE(PG8_SB(0, 0), cB, voffB); PG8_STAGE(PG8_SB(0, 1), cB + hstepB, voffB); PG8_STAGE(PG8_SA(0, 0), cA, voffA); PG8_STAGE(PG8_SA(0, 1), cA + hstepA, voffA);
    if (wr == 1) PG8_BAR;
    PG8_WAIT_V(2); PG8_BAR;
    PG8_STAGE(PG8_SB(1, 0), cB + kstep, voffB); PG8_STAGE(PG8_SA(1, 0), cA + kstep, voffA); PG8_STAGE(PG8_SB(1, 1), cB + hstepB + kstep, voffB);
    PG8_WAIT_V(6); PG8_BAR;
    for (;;) {
        const bool has_next = S.next(ui + 1, nxt);
        const char* nA = has_next ? (const char*)g.A + (size_t)nxt.pm * tstepA : cA; const char* nB = has_next ? (const char*)g.Bt + (size_t)nxt.pn * tstepB : cB;
        for (int t = 0; t < nt; t += 2) {
            const bool last = (t == nt - 2);
            const char* a1 = cA + (size_t)(t + 1) * kstep;
            const char* a2 = last ? nA : cA + (size_t)(t + 2) * kstep; const char* b2 = last ? nB : cB + (size_t)(t + 2) * kstep;
            const char* a3 = a2 + kstep; const char* b3 = b2 + kstep;
            PG8_LDB(B0, 0, 0); PG8_LDB(B1, 0, 1); PG8_SCHED; PG8_LDA(At, 0, 0); PG8_STAGE(PG8_SA(1, 1), a1 + hstepA, voffA);
            PG8_WAIT_V(8); PG8_WAIT_L(0); PG8_BAR; PG8_MMA(0, 0, At, B0); PG8_MMA(0, 1, At, B1); PG8_BAR; PG8_SCHED;
            PG8_LDA(At, 0, 1); PG8_STAGE(PG8_SB(0, 0), b2, voffB); PG8_STAGE(PG8_SB(0, 1), b2 + hstepB, voffB); PG8_STAGE(PG8_SA(0, 0), a2, voffA);
            PG8_WAIT_V(8); PG8_WAIT_L(0); PG8_BAR; PG8_MMA(1, 0, At, B0); PG8_MMA(1, 1, At, B1); PG8_BAR; PG8_SCHED;
            PG8_LDB(B0, 1, 0); PG8_LDB(B1, 1, 1); PG8_SCHED; PG8_LDA(At, 1, 0); PG8_STAGE(PG8_SA(0, 1), a2 + hstepA, voffA);
            PG8_WAIT_V(8); PG8_WAIT_L(0); PG8_BAR; PG8_MMA(0, 0, At, B0); PG8_MMA(0, 1, At, B1); PG8_BAR; PG8_SCHED;
            PG8_LDA(At, 1, 1); PG8_STAGE(PG8_SB(1, 0), b3, voffB); PG8_STAGE(PG8_SB(1, 1), b3 + hstepB, voffB); PG8_STAGE(PG8_SA(1, 0), a3, voffA);
            PG8_WAIT_V(8); PG8_WAIT_L(0); PG8_BAR; PG8_MMA(1, 0, At, B0); PG8_MMA(1, 1, At, B1); PG8_BAR; PG8_SCHED;
        }
        if constexpr (ALIGN_EPI) { if (wr == 0) PG8_BAR; }
        E(acc, cur, wr, wc, fr, fq);
        if (!has_next) break;
#pragma unroll
        for (int a = 0; a < 2; ++a)
#pragma unroll
            for (int b = 0; b < 2; ++b)
#pragma unroll
                for (int m = 0; m < 4; ++m)
#pragma unroll
                    for (int n = 0; n < 2; ++n) acc[a][b][m][n] = (f32x4){0.f, 0.f, 0.f, 0.f};
        cur = nxt; cA = nA; cB = nB; ++ui;
        if constexpr (ALIGN_EPI) { if (wr == 1) PG8_BAR; }
    }
    PG8_WAIT_V(0);
    if constexpr (!ALIGN_EPI) { if (wr == 0) PG8_BAR; }
    PG8_BAR;
#undef PG8_SA
#undef PG8_SB
#undef PG8_STAGE
#undef PG8_LDA
#undef PG8_LD8
#undef PG8_LDB
#undef PG8_MMA
#undef PG8_CAT8
#undef PG8_WAIT_V
#undef PG8_WAIT_L
#undef PG8_BAR
#undef PG8_SCHED
}

typedef const f32x4 (&AccRef)[2][2][4][2];
__device__ __forceinline__ u32x4 pack8(f32x4 v0, f32x4 v1) { u32x4 w; w.x = cvt_pk_bf16(v0[0], v0[1]); w.y = cvt_pk_bf16(v0[2], v0[3]); w.z = cvt_pk_bf16(v1[0], v1[1]); w.w = cvt_pk_bf16(v1[2], v1[3]); return w; }

template <bool F8> struct EpiSwiglu {
    static constexpr bool PERM = true;
    bf16_t* O;
    __device__ __forceinline__ void operator()(AccRef acc, const Unit& u, int wr, int wc, int fr, int fq) const {
        constexpr int col_base = F8 ? FIN_BF_TILES * 128 : 0; constexpr float sc = F8 ? 1.f / G8_SCALE : 1.f;
        const int row0 = u.pm * BM + wr * 64 + fr, col0 = col_base + u.pn * HALF + wc * 32 + 8 * fq;
#pragma unroll
        for (int ai = 0; ai < 2; ++ai)
#pragma unroll
            for (int m = 0; m < 4; ++m) {
                bf16_t* p = O + (size_t)(row0 + ai * HALF + m * 16) * DFF + col0;
                const f32x4 v0 = swiglu_pk4<F8>(acc[ai][0][m][0], acc[ai][1][m][0]), v1 = swiglu_pk4<F8>(acc[ai][0][m][1], acc[ai][1][m][1]);
                *(u32x4*)p = pack8(v0, v1);
                if constexpr (F8) asm volatile("" ::: "memory");
            }
    }
};
template <bool LN> struct EpiResidT {
    static constexpr bool PERM = false;
    const float* hin; float* R; const float* gate; float gs; const float* stats; const float* lng; const float* lnb;
    __device__ __forceinline__ void operator()(AccRef acc, const Unit& u, int wr, int wc, int fr, int fq) const {
        const int row0 = u.pm * BM + wr * 64 + fr, col0 = u.pn * BM + wc * 32 + 4 * fq;
        const float* gp = gate + (size_t)(u.pm >> 4) * NMOD + col0;
        f32x2_t st[2][4];
#pragma unroll
        for (int ai = 0; ai < 2; ++ai)
#pragma unroll
            for (int m = 0; m < 4; ++m) { if constexpr (LN) st[ai][m] = *(const f32x2_t*)(stats + 2 * (size_t)(row0 + ai * HALF + m * 16)); else st[ai][m] = (f32x2_t){0.f, 1.f}; }
#pragma unroll
        for (int bj = 0; bj < 2; ++bj)
#pragma unroll
            for (int n = 0; n < 2; ++n) {
                const int co = bj * HALF + 16 * n;
                const f32x4 gv = *(const f32x4*)(gp + co) * gs;
                f32x4 lg4 = (f32x4){1.f, 1.f, 1.f, 1.f}, lb4 = (f32x4){0.f, 0.f, 0.f, 0.f};
                if constexpr (LN) { lg4 = *(const f32x4*)(lng + col0 + co); lb4 = *(const f32x4*)(lnb + col0 + co); }
                f32x4 hv[2][4];
#pragma unroll
                for (int ai = 0; ai < 2; ++ai)
#pragma unroll
                    for (int m = 0; m < 4; ++m) hv[ai][m] = *(const f32x4*)(hin + (size_t)(row0 + ai * HALF + m * 16) * DM + col0 + co);
#pragma unroll
                for (int ai = 0; ai < 2; ++ai)
#pragma unroll
                    for (int m = 0; m < 4; ++m) { const size_t off = (size_t)(row0 + ai * HALF + m * 16) * DM + col0 + co;
                        f32x4 h = hv[ai][m];
                        if constexpr (LN) h = (h - st[ai][m][0]) * st[ai][m][1] * lg4 + lb4;
                        *(f32x4*)(R + off) = h * ALPHA + gv * acc[ai][bj][m][n]; }
            }
    }
};
struct EpiMix {
    static constexpr bool PERM = true;
    bf16_t* MIX; bf16_t* GATES;
    __device__ __forceinline__ void operator()(AccRef acc, const Unit& u, int wr, int wc, int fr, int fq) const {
        const int row0 = u.pm * BM + wr * 64 + fr; int colt = u.pn * BM; bf16_t* base = MIX; int ldc = MIXP;
        if (colt >= 6144) { base = GATES; ldc = GP; colt -= 6144; }
        const int col0 = colt + wc * 32 + 8 * fq;
#pragma unroll
        for (int ai = 0; ai < 2; ++ai)
#pragma unroll
            for (int m = 0; m < 4; ++m) { bf16_t* p = base + (size_t)(row0 + ai * HALF + m * 16) * ldc + col0;
#pragma unroll
                for (int bj = 0; bj < 2; ++bj) *(u32x4*)(p + bj * HALF) = pack8(acc[ai][bj][m][0], acc[ai][bj][m][1]); }
    }
};
struct EpiGates8 {
    static constexpr bool PERM = true;
    bf16_t* GATES;
    __device__ __forceinline__ void operator()(AccRef acc, const Unit& u, int wr, int wc, int fr, int fq) const {
        const int row0 = u.pm * BM + wr * 64 + fr, col0 = u.pn * BM + wc * 32 + 8 * fq; const float sc = 1.f / G8_SCALE;
#pragma unroll
        for (int ai = 0; ai < 2; ++ai)
#pragma unroll
            for (int m = 0; m < 4; ++m) { bf16_t* p = GATES + (size_t)(row0 + ai * HALF + m * 16) * GP + col0;
#pragma unroll
                for (int bj = 0; bj < 2; ++bj) *(u32x4*)(p + bj * HALF) = pack8(acc[ai][bj][m][0] * sc, acc[ai][bj][m][1] * sc); }
    }
};
template <bool SECOND> struct EpiGate {
    static constexpr bool PERM = true;
    const bf16_t* G;
    bf16_t* T;
    bf16_t* OUT;
    __device__ __forceinline__ void operator()(AccRef acc, const Unit& u, int wr, int wc, int fr, int fq) const {
        const int row0 = u.pm * BM + wr * 64 + fr, col0 = u.pn * BM + wc * 32 + 8 * fq;
#pragma unroll
        for (int ai = 0; ai < 2; ++ai)
#pragma unroll
            for (int bj = 0; bj < 2; ++bj) {
                u32x4 gw[4], tw[4];
#pragma unroll
                for (int m = 0; m < 4; ++m) { const size_t row = (size_t)(row0 + ai * HALF + m * 16);
                    gw[m] = *(const u32x4*)(G + row * GP + col0 + bj * HALF);
                    if constexpr (SECOND) tw[m] = *(const u32x4*)(T + row * DM + col0 + bj * HALF); }
#pragma unroll
                for (int m = 0; m < 4; ++m) { const size_t row = (size_t)(row0 + ai * HALF + m * 16);
                    f32x4 v0 = gate_pk4(acc[ai][bj][m][0], gw[m].x, gw[m].y), v1 = gate_pk4(acc[ai][bj][m][1], gw[m].z, gw[m].w);
                    if constexpr (SECOND) {
                        v0[0] += bf_lo(tw[m].x); v0[1] += bf_hi(tw[m].x); v0[2] += bf_lo(tw[m].y); v0[3] += bf_hi(tw[m].y);
                        v1[0] += bf_lo(tw[m].z); v1[1] += bf_hi(tw[m].z); v1[2] += bf_lo(tw[m].w); v1[3] += bf_hi(tw[m].w);
                        *(u32x4*)(OUT + row * MIXP + col0 + bj * HALF) = pack8(v0, v1);
                    } else {
                        *(u32x4*)(T + row * DM + col0 + bj * HALF) = pack8(v0, v1);
                    }
                }
            }
    }
};
}

struct Args { const float* in[22]; float* out; unsigned char* ws; int ph_lo, ph_hi; };
enum { I_X = 0, I_C, I_WADA, I_BADA, I_F1IN, I_F1OUT, I_LN1G, I_LN1B, I_WMIX, I_RELB, I_WA2, I_BAL, I_GNG, I_WPA, I_WPB, I_WMO, I_LN2G, I_LN2B, I_F2IN, I_F2OUT, I_LN3G, I_LN3B };

struct Ctx {
    LAS unsigned char* lds; int tid, lane, wave, G, bx;
    const Args* a;
};

__device__ __forceinline__ void tr_item(const float* W, int ldw, int K, int k0, int c0, bf16_t* WT, int r0, int ncols, LAS float* scr, int lane) {
    const int cl = lane & 31;
    float tv[32];
#pragma unroll
    for (int i = 0; i < 32; ++i) { const int kk = 2 * i + (lane >> 5); tv[i] = (cl < ncols) ? W[(size_t)(k0 + kk) * ldw + c0 + cl] : 0.f; }
#pragma unroll
    for (int i = 0; i < 32; ++i) { const int kk = 2 * i + (lane >> 5); scr[kk * 33 + cl] = tv[i]; }
    asm volatile("s_waitcnt lgkmcnt(0)" ::: "memory");
    const int c = lane & 7;
#pragma unroll
    for (int j = 0; j < 4; ++j) { const int n = (lane >> 3) + 8 * j; const LAS float* s = scr + (8 * c) * 33 + n;
        u32x4 o; o.x = cvt_pk_bf16(s[0 * 33], s[1 * 33]); o.y = cvt_pk_bf16(s[2 * 33], s[3 * 33]); o.z = cvt_pk_bf16(s[4 * 33], s[5 * 33]); o.w = cvt_pk_bf16(s[6 * 33], s[7 * 33]);
        if (n < ncols) *(u32x4*)(WT + (size_t)(r0 + n) * K + k0 + 8 * c) = o; }
    asm volatile("s_waitcnt lgkmcnt(0)" ::: "memory");
}

__device__ __forceinline__ unsigned pk4_fp8(float a, float b, float c, float d) { int w = 0; w = __builtin_amdgcn_cvt_pk_fp8_f32(a, b, w, false); w = __builtin_amdgcn_cvt_pk_fp8_f32(c, d, w, true); return (unsigned)w; }
__device__ __forceinline__ void tr_item8(const float* W, int ldw, int K, int k0, int c0, unsigned char* W8, int r0, LAS float* scr, int lane) {
    const int cl = lane & 31;
    float tv[32];
#pragma unroll
    for (int i = 0; i < 32; ++i) { const int kk = 2 * i + (lane >> 5); tv[i] = W[(size_t)(k0 + kk) * ldw + c0 + cl] * G8_SCALE; }
#pragma unroll
    for (int i = 0; i < 32; ++i) { const int kk = 2 * i + (lane >> 5); scr[kk * 33 + cl] = tv[i]; }
    asm volatile("s_waitcnt lgkmcnt(0)" ::: "memory");
    const int c = lane & 3;
#pragma unroll
    for (int j = 0; j < 2; ++j) { const int n = (lane >> 2) + 16 * j; const LAS float* s = scr + (16 * c) * 33 + n;
        u32x4 o; o.x = pk4_fp8(s[0 * 33], s[1 * 33], s[2 * 33], s[3 * 33]); o.y = pk4_fp8(s[4 * 33], s[5 * 33], s[6 * 33], s[7 * 33]);
        o.z = pk4_fp8(s[8 * 33], s[9 * 33], s[10 * 33], s[11 * 33]); o.w = pk4_fp8(s[12 * 33], s[13 * 33], s[14 * 33], s[15 * 33]);
        *(u32x4*)(W8 + (size_t)(r0 + n) * K + k0 + 16 * c) = o; }
    asm volatile("s_waitcnt lgkmcnt(0)" ::: "memory");
}

__device__ __forceinline__ void p0_prologue(const Ctx& X) {
    const Args& a = *X.a; unsigned char* ws = a.ws;
    LAS float* sl = (LAS float*)X.lds;
    LAS float* red = (LAS float*)(X.lds + 32768);
    for (int i = X.tid; i < 4 * DM; i += 512) sl[i] = fast_silu(a.in[I_C][i]);
    __syncthreads();
    float* mod = (float*)(ws + WS_MOD);
    for (int it = X.bx; it < NMOD / 64; it += X.G) {
        const int j0 = it * 64; const float* wp = a.in[I_WADA] + (size_t)(256 * X.wave) * NMOD + j0 + X.lane;
        float a0 = 0.f, a1 = 0.f, a2 = 0.f, a3 = 0.f;
        for (int k8 = 0; k8 < 256; k8 += 32) { float wv[32];
#pragma unroll
            for (int q = 0; q < 32; ++q) wv[q] = wp[(size_t)(k8 + q) * NMOD];
#pragma unroll
            for (int q = 0; q < 32; ++q) { const int k = 256 * X.wave + k8 + q; a0 += sl[k] * wv[q]; a1 += sl[DM + k] * wv[q]; a2 += sl[2 * DM + k] * wv[q]; a3 += sl[3 * DM + k] * wv[q]; } }
        red[(X.wave * 4 + 0) * 64 + X.lane] = a0; red[(X.wave * 4 + 1) * 64 + X.lane] = a1; red[(X.wave * 4 + 2) * 64 + X.lane] = a2; red[(X.wave * 4 + 3) * 64 + X.lane] = a3;
        __syncthreads();
        if (X.tid < 256) { const int b = X.tid >> 6, l = X.tid & 63; float s = a.in[I_BADA][j0 + l];
#pragma unroll
            for (int w = 0; w < 8; ++w) s += red[(w * 4 + b) * 64 + l];
            mod[(size_t)b * NMOD + j0 + l] = s; }
        __syncthreads();
    }
    __syncthreads();
    LAS float* scr = (LAS float*)(X.lds + X.wave * 16384);
    const int gw = X.bx * 8 + X.wave, NGW = X.G * 8;
    constexpr int I_FIN = 32 * 352, I_FOUT = 88 * 64, I_MIX = 32 * 320, I_LR = 32, I_P = 16 * 64, I_MO = 32 * 64;
    constexpr int NITEMS = 2 * I_FIN + 2 * I_FOUT + I_MIX + I_LR + 2 * I_P + I_MO;
    for (int it = gw; it < NITEMS; it += NGW) {
        int r = it;
        if (r < 2 * I_FIN) { const int which = r >= I_FIN; r -= which * I_FIN; const int kb = r / 352, nb = r % 352, c0 = 32 * nb, bj = c0 / DFF, j = c0 % DFF;
            const int rd = 256 * (j / 128) + 128 * bj + (j % 128);
            if (rd < FIN_BF_TILES * 256) tr_item(a.in[which ? I_F2IN : I_F1IN], 2 * DFF, DM, 64 * kb, c0, (bf16_t*)(ws + (which ? WS_W2IN : WS_W1IN)), rd, 32, scr, X.lane);
            else tr_item8(a.in[which ? I_F2IN : I_F1IN], 2 * DFF, DM, 64 * kb, c0, ws + (which ? WS_W2IN8 : WS_W1IN8), rd - FIN_BF_TILES * 256, scr, X.lane);
            continue; }
        r -= 2 * I_FIN;
        if (r < 2 * I_FOUT) { const int which = r >= I_FOUT; r -= which * I_FOUT; const int kb = r / 64, nb = r % 64;
            tr_item(a.in[which ? I_F2OUT : I_F1OUT], DM, DFF, 64 * kb, 32 * nb, (bf16_t*)(ws + (which ? WS_W2OUT : WS_W1OUT)), 32 * nb, 32, scr, X.lane); continue; }
        r -= 2 * I_FOUT;
        if (r < I_MIX) { const int kb = r / 320, nb = r % 320, r0 = 32 * nb, c0 = r0 < 6144 ? r0 : r0 + 16;
            if (r0 < 6144) tr_item(a.in[I_WMIX], WMIX_SRC_LD, DM, 64 * kb, c0, (bf16_t*)(ws + WS_WMIX), r0, 32, scr, X.lane);
            else tr_item8(a.in[I_WMIX], WMIX_SRC_LD, DM, 64 * kb, c0, ws + WS_WG8, r0 - 6144, scr, X.lane);
            continue; }
        r -= I_MIX;
        if (r < I_LR) { tr_item(a.in[I_WMIX], WMIX_SRC_LD, DM, 64 * r, 6144, (bf16_t*)(ws + WS_WLR), 0, 16, scr, X.lane); continue; }
        r -= I_LR;
        if (r < 2 * I_P) { const int which = r >= I_P; r -= which * I_P; const int kb = r / 64, nb = r % 64;
            tr_item(a.in[which ? I_WPB : I_WPA], DM, 1024, 64 * kb, 32 * nb, (bf16_t*)(ws + (which ? WS_WPB : WS_WPA)), 32 * nb, 32, scr, X.lane); continue; }
        r -= 2 * I_P;
        { const int kb = r / 64, nb = r % 64; tr_item(a.in[I_WMO], DM, DM, 64 * kb, 32 * nb, (bf16_t*)(ws + WS_WMO), 32 * nb, 32, scr, X.lane); }
    }
}

__device__ __forceinline__ void p_modulate(const Ctx& X, const float* x, const float* mod, int sh_off, bf16_t* U, unsigned char* U8) {
    const size_t n8 = (size_t)M_TOK * DM / 8;
    for (size_t i = (size_t)X.bx * 512 + X.tid; i < n8; i += (size_t)X.G * 512) {
        const int row = (int)(i >> 8), c8 = (int)(i & 255) * 8; const float* mp = mod + (size_t)(row >> 12) * NMOD + sh_off + c8;
        const f32x4 x0 = *(const f32x4*)(x + (size_t)row * DM + c8), x1 = *(const f32x4*)(x + (size_t)row * DM + c8 + 4);
        const f32x4 s0 = *(const f32x4*)(mp), s1 = *(const f32x4*)(mp + 4), c0 = *(const f32x4*)(mp + DM), c1 = *(const f32x4*)(mp + DM + 4);
        const f32x4 u0 = x0 * (1.f + c0) + s0, u1 = x1 * (1.f + c1) + s1;
        *(u32x4*)(U + (size_t)row * DM + c8) = pg8::pack8(u0, u1);
        u32x2 w8; w8.x = pk4_fp8(u0[0], u0[1], u0[2], u0[3]); w8.y = pk4_fp8(u1[0], u1[1], u1[2], u1[3]); *(u32x2*)(U8 + (size_t)row * DM + c8) = w8;
    }
}

template <bool LAST, bool F8 = false>
__device__ __forceinline__ void p_layernorm(const Ctx& X, const float* R, const float* lg, const float* lb, float* Hout, float* stats, const float* mod, int sh_off, bf16_t* U, unsigned char* U8 = nullptr) {
    const int gw = X.bx * 8 + X.wave, NGW = X.G * 8;
    for (int row = gw; row < M_TOK; row += NGW) {
        const float* rp = R + (size_t)row * DM + 4 * X.lane;
        f32x4 v[8]; float s = 0.f;
#pragma unroll
        for (int j = 0; j < 8; ++j) { v[j] = *(const f32x4*)(rp + 256 * j); s += (v[j][0] + v[j][1]) + (v[j][2] + v[j][3]); }
        const float mean = wave_sum(s) * (1.f / DM); float s2 = 0.f;
#pragma unroll
        for (int j = 0; j < 8; ++j) { v[j] = v[j] - mean; s2 += (v[j][0] * v[j][0] + v[j][1] * v[j][1]) + (v[j][2] * v[j][2] + v[j][3] * v[j][3]); }
        const float rstd = 1.f / sqrtf(wave_sum(s2) * (1.f / DM) + LN_EPS);
        const float* mp = LAST ? nullptr : mod + (size_t)(row >> 12) * NMOD + sh_off + 4 * X.lane;
        if constexpr (!LAST) { if (X.lane == 0) *(f32x2_t*)(stats + 2 * (size_t)row) = (f32x2_t){mean, rstd}; }
#pragma unroll
        for (int j = 0; j < 8; ++j) {
            const f32x4 g4 = *(const f32x4*)(lg + 4 * X.lane + 256 * j), b4 = *(const f32x4*)(lb + 4 * X.lane + 256 * j);
            const f32x4 y = v[j] * rstd * g4 + b4;
            if constexpr (LAST) *(f32x4*)(Hout + (size_t)row * DM + 4 * X.lane + 256 * j) = y;
            if constexpr (!LAST) { const f32x4 sh = *(const f32x4*)(mp + 256 * j), sc = *(const f32x4*)(mp + DM + 256 * j); const f32x4 uu = y * (1.f + sc) + sh;
                u32x2 w; w.x = cvt_pk_bf16(uu[0], uu[1]); w.y = cvt_pk_bf16(uu[2], uu[3]); *(u32x2*)(U + (size_t)row * DM + 4 * X.lane + 256 * j) = w;
                if constexpr (F8) *(unsigned*)(U8 + (size_t)row * DM + 4 * X.lane + 256 * j) = pk4_fp8(uu[0], uu[1], uu[2], uu[3]); }
        }
    }
}

__device__ __forceinline__ s16x4 tr_read(const LAS unsigned char* p) { return __builtin_bit_cast(s16x4, __builtin_amdgcn_ds_read_tr16_b64_v4i16((LAS s16x4*)p)); }
__device__ __forceinline__ bf16x8 cat8(s16x4 a, s16x4 b) { return (bf16x8){a[0], a[1], a[2], a[3], b[0], b[1], b[2], b[3]}; }

constexpr int KD_P = 1088, V_P = 576, OT_P = 528;
constexpr int L1_RED = 0, L1_LRS = 32768, L1_KD = 36864, L1_V = L1_KD + 64 * KD_P, L1_END = L1_V + 64 * V_P;
static_assert(L1_END <= 147456, "gla chunk LDS");

__device__ __forceinline__ void p_gla_chunk(const Ctx& X, const bf16_t* U, const bf16_t* WLR, const bf16_t* MIX, float* DEC, bf16_t* UB, const float* wa2, const float* bal) {
    LAS unsigned char* lds = X.lds;
    LAS float* red = (LAS float*)(lds + L1_RED);
    LAS float* lrs = (LAS float*)(lds + L1_LRS);
    const int tid = X.tid, lane = X.lane, w = X.wave, l15 = lane & 15, g = lane >> 4;
    const int tr_row = 8 * g + (l15 >> 2), tr_col = 4 * (l15 & 3);
    const int vr = tid >> 5, vc = tid & 31;
    for (int ch = X.bx; ch < 256; ch += X.G) {
        const size_t t0 = (size_t)ch * 64;
        f32x4 acc[4];
#pragma unroll
        for (int mi = 0; mi < 4; ++mi) acc[mi] = (f32x4){0.f, 0.f, 0.f, 0.f};
        const int kw = 256 * w + 8 * g;
#pragma unroll
        for (int s = 0; s < 8; ++s) {
            const bf16x8 bfr = *(const bf16x8*)(WLR + (size_t)l15 * DM + kw + 32 * s);
#pragma unroll
            for (int mi = 0; mi < 4; ++mi) { const bf16x8 afr = *(const bf16x8*)(U + (t0 + 16 * mi + l15) * DM + kw + 32 * s);
                acc[mi] = __builtin_amdgcn_mfma_f32_16x16x32_bf16(afr, bfr, acc[mi], 0, 0, 0); }
        }
#pragma unroll
        for (int mi = 0; mi < 4; ++mi)
#pragma unroll
            for (int e = 0; e < 4; ++e) red[(w * 64 + 16 * mi + 4 * g + e) * 16 + l15] = acc[mi][e];
        __syncthreads();
        for (int i = tid; i < 1024; i += 512) { float s = 0.f;
#pragma unroll
            for (int ww = 0; ww < 8; ++ww) s += red[ww * 1024 + i];
            lrs[i] = s; }
        __syncthreads();
        {   const int kp = tid;
            float wa[16];
#pragma unroll
            for (int r = 0; r < 16; ++r) wa[r] = wa2[r * 512 + kp];
            const float ba = bal[kp];
            float cum[64]; float run = 0.f;
#pragma unroll
            for (int c = 0; c < 64; ++c) {
                float z = ba;
#pragma unroll
                for (int r4 = 0; r4 < 4; ++r4) { const f32x4 l4 = *(const LAS f32x4*)(lrs + c * 16 + 4 * r4);
                    z += l4[0] * wa[4 * r4] + l4[1] * wa[4 * r4 + 1] + l4[2] * wa[4 * r4 + 2] + l4[3] * wa[4 * r4 + 3]; }
                const float ls = fminf(z, 0.f) - __logf(1.f + __expf(-fabsf(z)));
                run += ls * (1.f / 16.f); cum[c] = run;
            }
            DEC[(size_t)ch * 512 + kp] = __expf(run);
            const bf16_t* kptr = MIX + t0 * MIXP + C_KB + kp;
#pragma unroll
            for (int c = 0; c < 64; ++c) { const float kv = __uint_as_float((unsigned)kptr[(size_t)c * MIXP] << 16); const float kd = kv * __expf(run - cum[c]);
                *(LAS bf16_t*)(lds + L1_KD + c * KD_P + kp * 2) = (bf16_t)(cvt_pk_bf16(kd, 0.f) & 0xffffu); }
        }
        for (int h = 0; h < 4; ++h) {
            u32x4 pv[4];
#pragma unroll
            for (int i = 0; i < 4; ++i) pv[i] = *(const u32x4*)(MIX + (t0 + vr + 16 * i) * MIXP + C_VB + h * 256 + vc * 8);
            __syncthreads();
#pragma unroll
            for (int i = 0; i < 4; ++i) *(LAS u32x4*)(lds + L1_V + (vr + 16 * i) * V_P + vc * 16) = pv[i];
            __syncthreads();
            f32x4 uacc[2][8];
#pragma unroll
            for (int vt = 0; vt < 2; ++vt)
#pragma unroll
                for (int kt = 0; kt < 8; ++kt) uacc[vt][kt] = (f32x4){0.f, 0.f, 0.f, 0.f};
#pragma unroll
            for (int s = 0; s < 2; ++s) {
                bf16x8 va[2];
#pragma unroll
                for (int vt = 0; vt < 2; ++vt) { const LAS unsigned char* p = lds + L1_V + (32 * s + tr_row) * V_P + (32 * w + 16 * vt + tr_col) * 2; va[vt] = cat8(tr_read(p), tr_read(p + 4 * V_P)); }
#pragma unroll
                for (int kt = 0; kt < 8; ++kt) { const LAS unsigned char* p = lds + L1_KD + (32 * s + tr_row) * KD_P + (h * 128 + 16 * kt + tr_col) * 2;
                    const bf16x8 kf = cat8(tr_read(p), tr_read(p + 4 * KD_P));
                    uacc[0][kt] = __builtin_amdgcn_mfma_f32_16x16x32_bf16(va[0], kf, uacc[0][kt], 0, 0, 0);
                    uacc[1][kt] = __builtin_amdgcn_mfma_f32_16x16x32_bf16(va[1], kf, uacc[1][kt], 0, 0, 0); }
            }
            bf16_t* up = UB + ((size_t)(ch * 4 + h) * 128) * 256;
#pragma unroll
            for (int vt = 0; vt < 2; ++vt)
#pragma unroll
                for (int kt = 0; kt < 8; ++kt) { u32x2 o; o.x = cvt_pk_bf16(uacc[vt][kt][0], uacc[vt][kt][1]); o.y = cvt_pk_bf16(uacc[vt][kt][2], uacc[vt][kt][3]);
                    *(u32x2*)(up + (size_t)(16 * kt + l15) * 256 + 32 * w + 16 * vt + 4 * g) = o; }
        }
        __syncthreads();
    }
}

__device__ __forceinline__ void p_gla_scan_elem(const Ctx& X, const float* DEC, const bf16_t* UB, bf16_t* ST) {
    for (int idx = X.bx * 512 + X.tid; idx < 4 * 4 * 128 * 64; idx += X.G * 512) {
        const int vq = idx & 63, k = (idx >> 6) & 127, h = (idx >> 13) & 3, b = idx >> 15;
        const size_t off0 = ((size_t)((b * 64) * 4 + h) * 128 + k) * 256 + 4 * vq;
        const bf16_t* p0 = UB + off0; bf16_t* s0 = ST + off0;
        const float* d0 = DEC + (size_t)(b * 64) * 512 + h * 128 + k;
        f32x4 st = (f32x4){0.f, 0.f, 0.f, 0.f};
        for (int n8 = 0; n8 < 64; n8 += 8) {
            u32x2 uv[8]; float dv[8];
#pragma unroll
            for (int q = 0; q < 8; ++q) { uv[q] = *(const u32x2*)(p0 + (size_t)(n8 + q) * (4 * 128 * 256)); dv[q] = d0[(size_t)(n8 + q) * 512]; }
#pragma unroll
            for (int q = 0; q < 8; ++q) { const f32x4 uu = (f32x4){bf_lo(uv[q].x), bf_hi(uv[q].x), bf_lo(uv[q].y), bf_hi(uv[q].y)}; st = st * dv[q] + uu;
                u32x2 o; o.x = cvt_pk_bf16(st[0], st[1]); o.y = cvt_pk_bf16(st[2], st[3]); *(u32x2*)(s0 + (size_t)(n8 + q) * (4 * 128 * 256)) = o; }
        }
    }
}

constexpr int L3_S = 0, L3_SS = 128 * V_P, L3_OT = L3_SS + 2048, L3_END = L3_OT + 64 * OT_P;
static_assert(L3_END <= 131072, "gla readout LDS");
__device__ __forceinline__ void p_gla_readout(const Ctx& X, bf16_t* MIX, const bf16_t* UB, const float* gng) {
    LAS unsigned char* lds = X.lds;
    const int tid = X.tid, lane = X.lane, w = X.wave, l15 = lane & 15, g = lane >> 4;
    const int tr_row = 8 * g + (l15 >> 2), tr_col = 4 * (l15 & 3);
    const int vr = tid >> 5, vc = tid & 31;
    const float qscale = 0.08838834764831845f;
    for (int uid = X.bx; uid < 1024; uid += X.G) {
        const int ch = uid >> 2, h = uid & 3; const size_t t0 = (size_t)ch * 64;
        const bf16_t* sp = UB + ((size_t)(ch * 4 + h) * 128) * 256;
        u32x4 sv[8], rbv[4];
#pragma unroll
        for (int i = 0; i < 8; ++i) sv[i] = *(const u32x4*)(sp + (size_t)(vr + 16 * i) * 256 + vc * 8);
#pragma unroll
        for (int i = 0; i < 4; ++i) rbv[i] = *(const u32x4*)(MIX + (t0 + vr + 16 * i) * MIXP + C_RB + h * 256 + vc * 8);
        bf16x8 qf[4][4];
#pragma unroll
        for (int mc = 0; mc < 4; ++mc)
#pragma unroll
            for (int s = 0; s < 4; ++s) qf[mc][s] = *(const bf16x8*)(MIX + (t0 + 16 * mc + l15) * MIXP + C_QB + h * 128 + 32 * s + 8 * g);
#pragma unroll
        for (int i = 0; i < 8; ++i) *(LAS u32x4*)(lds + L3_S + (vr + 16 * i) * V_P + vc * 16) = sv[i];
        __syncthreads();
        f32x4 o[4][2];
#pragma unroll
        for (int mc = 0; mc < 4; ++mc) { o[mc][0] = (f32x4){0.f, 0.f, 0.f, 0.f}; o[mc][1] = (f32x4){0.f, 0.f, 0.f, 0.f}; }
#pragma unroll
        for (int s = 0; s < 4; ++s) {
            bf16x8 sb[2];
#pragma unroll
            for (int nt = 0; nt < 2; ++nt) { const LAS unsigned char* p = lds + L3_S + (32 * s + tr_row) * V_P + (32 * w + 16 * nt + tr_col) * 2; sb[nt] = cat8(tr_read(p), tr_read(p + 4 * V_P)); }
#pragma unroll
            for (int mc = 0; mc < 4; ++mc) { o[mc][0] = __builtin_amdgcn_mfma_f32_16x16x32_bf16(qf[mc][s], sb[0], o[mc][0], 0, 0, 0);
                o[mc][1] = __builtin_amdgcn_mfma_f32_16x16x32_bf16(qf[mc][s], sb[1], o[mc][1], 0, 0, 0); }
        }
#pragma unroll
        for (int mc = 0; mc < 4; ++mc) { f32x4 q2 = o[mc][0] * o[mc][0] + o[mc][1] * o[mc][1];
#pragma unroll
            for (int sh = 1; sh < 16; sh <<= 1) { q2[0] += __shfl_xor(q2[0], sh); q2[1] += __shfl_xor(q2[1], sh); q2[2] += __shfl_xor(q2[2], sh); q2[3] += __shfl_xor(q2[3], sh); }
            if (l15 == 0) *(LAS f32x4*)(lds + L3_SS + (w * 64 + 16 * mc + 4 * g) * 4) = q2; }
        __syncthreads();
#pragma unroll
        for (int mc = 0; mc < 4; ++mc) { f32x4 tot = (f32x4){0.f, 0.f, 0.f, 0.f};
#pragma unroll
            for (int ww = 0; ww < 8; ++ww) tot += *(const LAS f32x4*)(lds + L3_SS + (ww * 64 + 16 * mc + 4 * g) * 4);
#pragma unroll
            for (int e = 0; e < 4; ++e) { const float rs = qscale * __builtin_amdgcn_rsqf(tot[e] * (qscale * qscale / 256.f) + RMS_EPS);
#pragma unroll
                for (int nt = 0; nt < 2; ++nt) *(LAS bf16_t*)(lds + L3_OT + (16 * mc + 4 * g + e) * OT_P + (32 * w + 16 * nt + l15) * 2) = (bf16_t)(cvt_pk_bf16(o[mc][nt][e] * rs, 0.f) & 0xffffu); } }
        __syncthreads();
#pragma unroll
        for (int i = 0; i < 4; ++i) { const int row = vr + 16 * i; const u32x4 ot = *(const LAS u32x4*)(lds + L3_OT + row * OT_P + vc * 16);
            const f32x4 g0 = *(const f32x4*)(gng + vc * 8), g1 = *(const f32x4*)(gng + vc * 8 + 4); const u32x4 rb = rbv[i];
            f32x4 y0, y1;
            y0[0] = bf_lo(ot.x) * g0[0] * fast_silu(bf_lo(rb.x)); y0[1] = bf_hi(ot.x) * g0[1] * fast_silu(bf_hi(rb.x)); y0[2] = bf_lo(ot.y) * g0[2] * fast_silu(bf_lo(rb.y)); y0[3] = bf_hi(ot.y) * g0[3] * fast_silu(bf_hi(rb.y));
            y1[0] = bf_lo(ot.z) * g1[0] * fast_silu(bf_lo(rb.z)); y1[1] = bf_hi(ot.z) * g1[1] * fast_silu(bf_hi(rb.z)); y1[2] = bf_lo(ot.w) * g1[2] * fast_silu(bf_lo(rb.w)); y1[3] = bf_hi(ot.w) * g1[3] * fast_silu(bf_hi(rb.w));
            *(u32x4*)(MIX + (t0 + row) * MIXP + C_RB + h * 256 + vc * 8) = pg8::pack8(y0, y1); }
    }
}

__device__ __forceinline__ int crow(int r, int hi) { return (r & 3) + 8 * (r >> 2) + 4 * hi; }
constexpr int AV_P = 192, A_WAVE_BYTES = 64 * AV_P + 256, L_ABIAS = 8 * A_WAVE_BYTES;
static_assert(L_ABIAS + 16 * 320 * 4 <= 131072, "attention LDS");

__device__ __forceinline__ void attn_unit(const Ctx& X, bf16_t* MIX, int b, int h, int n, int half) {
    const int lane = X.lane, r32 = lane & 31, hi = lane >> 5;
    LAS unsigned char* wl = X.lds + X.wave * A_WAVE_BYTES;
    LAS float* wsf = (LAS float*)(wl + 64 * AV_P);
    const LAS float* bias2 = (const LAS float*)(X.lds + L_ABIAS) + h * 320;
    const size_t trow0 = (size_t)b * SEQ + n * 64 + half * 32;
    bf16x8 qr[4];
    { const bf16_t* Qp = MIX + (trow0 + r32) * MIXP + C_QA + h * 64 + hi * 8;
#pragma unroll
      for (int d0 = 0; d0 < 4; ++d0) qr[d0] = *(const bf16x8*)(Qp + d0 * 16); }
    f32x16 o0, o1;
#pragma unroll
    for (int r = 0; r < 16; ++r) { o0[r] = 0.f; o1[r] = 0.f; }
    float mrun = -1e30f, lrun = 0.f;
    const int vbase = (4 * hi + ((lane & 15) >> 2)) * AV_P + (16 * ((lane >> 4) & 1) + 4 * (lane & 3)) * 2;
    const float sc2 = 0.125f * LOG2E;
    const int j0 = (n >= 8 ? 0 : 8 - n);
    bf16x8 k0[4], k1[4]; u32x4 vv[8];
#define ATT_LOAD(j_) do { const size_t kv0_ = (size_t)b * SEQ + (size_t)(n - 8 + (j_)) * 64; \
        const bf16_t* Kp_ = MIX + (kv0_ + r32) * MIXP + C_KA + h * 64 + hi * 8; \
        _Pragma("unroll") for (int d0 = 0; d0 < 4; ++d0) { k0[d0] = *(const bf16x8*)(Kp_ + d0 * 16); k1[d0] = *(const bf16x8*)(Kp_ + (size_t)32 * MIXP + d0 * 16); } \
        const bf16_t* Vp_ = MIX + (kv0_ + (lane >> 3)) * MIXP + C_VA + h * 64 + (lane & 7) * 8; \
        _Pragma("unroll") for (int i = 0; i < 8; ++i) vv[i] = *(const u32x4*)(Vp_ + (size_t)(8 * i) * MIXP); } while (0)
    ATT_LOAD(j0);
    for (int j = j0; j < 9; ++j) {
#pragma unroll
        for (int i = 0; i < 8; ++i) *(LAS u32x4*)(wl + (8 * i + (lane >> 3)) * AV_P + (lane & 7) * 16) = vv[i];
        bf16x8 kc0[4], kc1[4];
#pragma unroll
        for (int d0 = 0; d0 < 4; ++d0) { kc0[d0] = k0[d0]; kc1[d0] = k1[d0]; }
        if (j + 1 < 9) ATT_LOAD(j + 1);
        f32x16 p0, p1;
#pragma unroll
        for (int r = 0; r < 16; ++r) { p0[r] = 0.f; p1[r] = 0.f; }
#pragma unroll
        for (int d0 = 0; d0 < 4; ++d0) { p0 = __builtin_amdgcn_mfma_f32_32x32x16_bf16(kc0[d0], qr[d0], p0, 0, 0, 0); p1 = __builtin_amdgcn_mfma_f32_32x32x16_bf16(kc1[d0], qr[d0], p1, 0, 0, 0); }
        if (j <= 3) { const float bc = bias2[0];
#pragma unroll
            for (int r = 0; r < 16; ++r) { p0[r] = p0[r] * sc2 + bc; p1[r] = p1[r] * sc2 + bc; }
        } else { const int rb = (j - 8) * 64 - (32 * half + r32) + 4 * hi + 256;
#pragma unroll
            for (int r = 0; r < 16; ++r) { const int c = (r & 3) + 8 * (r >> 2); const int i0 = max(rb + c, 0), i1 = max(rb + c + 32, 0);
                p0[r] = p0[r] * sc2 + bias2[i0]; p1[r] = p1[r] * sc2 + bias2[i1]; }
        }
        float mx = fmaxf(p0[0], p1[0]);
#pragma unroll
        for (int r = 1; r < 16; ++r) mx = fmaxf(mx, fmaxf(p0[r], p1[r]));
        mx = fmaxf(mx, __shfl_xor(mx, 32));
        const float mnew = fmaxf(mrun, mx), alpha = __builtin_amdgcn_exp2f(mrun - mnew); mrun = mnew;
        float rs = 0.f;
#pragma unroll
        for (int r = 0; r < 16; ++r) { p0[r] = __builtin_amdgcn_exp2f(p0[r] - mnew); p1[r] = __builtin_amdgcn_exp2f(p1[r] - mnew); rs += p0[r] + p1[r]; }
        lrun = lrun * alpha + rs;
        if (!__all(alpha == 1.0f)) {
        wsf[r32] = alpha;
#pragma unroll
        for (int g4 = 0; g4 < 4; ++g4) { const f32x4 a4 = *(const LAS f32x4*)(wsf + 8 * g4 + 4 * hi);
#pragma unroll
            for (int e = 0; e < 4; ++e) { o0[4 * g4 + e] *= a4[e]; o1[4 * g4 + e] *= a4[e]; } }
        }
        bf16x8 pa[4];
        { u32x4 t;
          t.x = cvt_pk_bf16(p0[0], p0[1]); t.y = cvt_pk_bf16(p0[2], p0[3]); t.z = cvt_pk_bf16(p0[4], p0[5]); t.w = cvt_pk_bf16(p0[6], p0[7]); pa[0] = __builtin_bit_cast(bf16x8, t);
          t.x = cvt_pk_bf16(p0[8], p0[9]); t.y = cvt_pk_bf16(p0[10], p0[11]); t.z = cvt_pk_bf16(p0[12], p0[13]); t.w = cvt_pk_bf16(p0[14], p0[15]); pa[1] = __builtin_bit_cast(bf16x8, t);
          t.x = cvt_pk_bf16(p1[0], p1[1]); t.y = cvt_pk_bf16(p1[2], p1[3]); t.z = cvt_pk_bf16(p1[4], p1[5]); t.w = cvt_pk_bf16(p1[6], p1[7]); pa[2] = __builtin_bit_cast(bf16x8, t);
          t.x = cvt_pk_bf16(p1[8], p1[9]); t.y = cvt_pk_bf16(p1[10], p1[11]); t.z = cvt_pk_bf16(p1[12], p1[13]); t.w = cvt_pk_bf16(p1[14], p1[15]); pa[3] = __builtin_bit_cast(bf16x8, t); }
#pragma unroll
        for (int kk = 0; kk < 4; ++kk) { const LAS unsigned char* p = wl + vbase + (16 * kk) * AV_P;
            const bf16x8 v0 = cat8(tr_read(p), tr_read(p + 8 * AV_P)), v1 = cat8(tr_read(p + 64), tr_read(p + 8 * AV_P + 64));
            o0 = __builtin_amdgcn_mfma_f32_32x32x16_bf16(pa[kk], v0, o0, 0, 0, 0);
            o1 = __builtin_amdgcn_mfma_f32_32x32x16_bf16(pa[kk], v1, o1, 0, 0, 0); }
    }
#undef ATT_LOAD
    lrun += __shfl_xor(lrun, 32);
    wsf[r32] = 1.f / lrun;
#pragma unroll
    for (int g4 = 0; g4 < 4; ++g4) { const f32x4 a4 = *(const LAS f32x4*)(wsf + 8 * g4 + 4 * hi);
#pragma unroll
        for (int e = 0; e < 4; ++e) { const int q = 8 * g4 + 4 * hi + e;
            *(LAS bf16_t*)(wl + q * 144 + r32 * 2) = (bf16_t)(cvt_pk_bf16(o0[4 * g4 + e] * a4[e], 0.f) & 0xffffu);
            *(LAS bf16_t*)(wl + q * 144 + 64 + r32 * 2) = (bf16_t)(cvt_pk_bf16(o1[4 * g4 + e] * a4[e], 0.f) & 0xffffu); } }
#pragma unroll
    for (int i = 0; i < 4; ++i) { const int row = 8 * i + (lane >> 3), chn = lane & 7; const u32x4 v = *(const LAS u32x4*)(wl + row * 144 + chn * 16);
        *(u32x4*)(MIX + (trow0 + row) * MIXP + C_QA + h * 64 + chn * 8) = v; }
}


#define XB_TMO      128
#define XB_XCNT(j)  (256  + 64 * (j))
#define XB_XSUB(j)  (1280 + 64 * (j))
#define XB_XGEN(j)  (2304 + 64 * (j))
#define XB_TOP      3328
#define XB_TOPGEN   3392
#define XCD_BAR_WORDS 3456
#define XB_SPIN_CAP (1u << 18)
__device__ __forceinline__ unsigned xb_ld(unsigned* p)              { return __hip_atomic_load(p, __ATOMIC_RELAXED, __HIP_MEMORY_SCOPE_AGENT); }
__device__ __forceinline__ unsigned xb_add(unsigned* p, unsigned v) { return __hip_atomic_fetch_add(p, v, __ATOMIC_RELAXED, __HIP_MEMORY_SCOPE_AGENT); }
__device__ __forceinline__ unsigned xb_xcc_id() { return (unsigned)__builtin_amdgcn_s_getreg((3 << 11) | 20) & 0xFu; }
#define XB_SPIN(cond, bar) do { unsigned _sp = 0; while (cond) { __builtin_amdgcn_s_sleep(1); \
    if ((++_sp & 255u) == 0u) { if (xb_ld(&(bar)[XB_TMO])) break; if (_sp > XB_SPIN_CAP) { atomicAdd(&(bar)[XB_TMO], 1u); break; } } } } while (0)
struct XcdBarrier { unsigned* bar; unsigned x; volatile LAS unsigned* st; };
__device__ __forceinline__ XcdBarrier xcd_barrier_post(unsigned* bar, volatile LAS unsigned* st) {
    XcdBarrier b; b.bar = bar; b.x = xb_xcc_id(); b.st = st;
    if (threadIdx.x == 0) (void)xb_add(&bar[XB_XCNT(b.x)], 1u);
    return b;
}
__device__ __forceinline__ void xcd_barrier_complete(unsigned* bar, unsigned x, unsigned& nloc, unsigned& nx) {
    const unsigned G = gridDim.x * gridDim.y * gridDim.z;
    unsigned sum, cnt, mine, sp = 0u;
    for (;;) {
        sum = 0u; cnt = 0u; mine = 0u;
#pragma unroll
        for (unsigned j = 0; j < 16; ++j) { const unsigned c = xb_ld(&bar[XB_XCNT(j)]); sum += c; cnt += (c > 0u) ? 1u : 0u; mine = (j == x) ? c : mine; }
        if (sum == G) break;
        __builtin_amdgcn_s_sleep(1);
        if ((++sp & 255u) == 0u) { if (xb_ld(&bar[XB_TMO])) break; if (sp > XB_SPIN_CAP) { atomicAdd(&bar[XB_TMO], 1u); break; } }
    }
    nloc = mine > 0u ? mine : 1u; nx = cnt > 0u ? cnt : 1u;
}
__device__ __forceinline__ void xcd_barrier(const XcdBarrier& b) {
    asm volatile("s_waitcnt vmcnt(0)" ::: "memory");
    __syncthreads();
    if (threadIdx.x == 0) {
        unsigned* bar = b.bar;
        __builtin_amdgcn_s_waitcnt(0);
        unsigned nloc = b.st[0], nx = b.st[1];
        if (nloc == 0u) { xcd_barrier_complete(bar, b.x, nloc, nx); b.st[0] = nloc; b.st[1] = nx; }
        const unsigned old = xb_add(&bar[XB_XSUB(b.x)], 1u);
        const unsigned gen = old / nloc;
        if (old + 1u == (gen + 1u) * nloc) {
            __builtin_amdgcn_fence(__ATOMIC_RELEASE, "agent");
            asm volatile("s_waitcnt vmcnt(0)" ::: "memory");
            const unsigned og = xb_add(&bar[XB_TOP], 1u);
            const unsigned tg = og / nx;
            if (og + 1u == (tg + 1u) * nx) xb_add(&bar[XB_TOPGEN], 1u);
            else XB_SPIN(xb_ld(&bar[XB_TOPGEN]) == tg, bar);
            __builtin_amdgcn_fence(__ATOMIC_ACQUIRE, "agent");
            xb_add(&bar[XB_XGEN(b.x)], 1u);
            asm volatile("s_waitcnt vmcnt(0)" ::: "memory");
        } else {
            XB_SPIN(xb_ld(&bar[XB_XGEN(b.x)]) == gen, bar);
            __builtin_amdgcn_fence(__ATOMIC_ACQUIRE, "agent");
            asm volatile("s_waitcnt vmcnt(0)" ::: "memory");
        }
    }
    __syncthreads();
}

__global__ void __launch_bounds__(512, 2) fwd_megakernel(Args args) {
    extern __shared__ __attribute__((aligned(16))) unsigned char lds_raw[];
    Ctx X; X.lds = (LAS unsigned char*)lds_raw; X.tid = threadIdx.x; X.lane = X.tid & 63; X.wave = __builtin_amdgcn_readfirstlane(X.tid >> 6); X.G = gridDim.x; X.bx = blockIdx.x; X.a = &args;
    unsigned char* ws = args.ws;
    float* mod = (float*)(ws + WS_MOD); float* DEC = (float*)(ws + WS_DEC);
    bf16_t* W1IN = (bf16_t*)(ws + WS_W1IN); bf16_t* W1OUT = (bf16_t*)(ws + WS_W1OUT); bf16_t* WMIX = (bf16_t*)(ws + WS_WMIX); bf16_t* WLR = (bf16_t*)(ws + WS_WLR);
    bf16_t* WPA = (bf16_t*)(ws + WS_WPA); bf16_t* WPB = (bf16_t*)(ws + WS_WPB); bf16_t* WMO = (bf16_t*)(ws + WS_WMO); bf16_t* W2IN = (bf16_t*)(ws + WS_W2IN); bf16_t* W2OUT = (bf16_t*)(ws + WS_W2OUT);
    bf16_t* U = (bf16_t*)(ws + WS_U); float* H = (float*)(ws + WS_H); bf16_t* ACT = (bf16_t*)(ws + WS_BIG); bf16_t* MIX = (bf16_t*)(ws + WS_BIG); bf16_t* UB = (bf16_t*)(ws + WS_UB); unsigned char* U8 = ws + WS_UB;     bf16_t* ST = (bf16_t*)(ws + WS_W1IN);
    float* R = args.out; bf16_t* GATES = (bf16_t*)(ws + WS_H); float* STATS = (float*)(ws + WS_STAT);
    const int lo = args.ph_lo, hi = args.ph_hi;
    cg::grid_group grid = cg::this_grid();
    volatile LAS unsigned* MISC = (volatile LAS unsigned*)(X.lds + LDS_MISC);
    if (X.tid < 16) MISC[X.tid] = 0u;
    __syncthreads();
    XcdBarrier bar; bar.bar = (unsigned*)(ws + WS_BAR); bar.x = 0; bar.st = nullptr;
    if (hi - lo > 1) { bar = xcd_barrier_post((unsigned*)(ws + WS_BAR), MISC); grid.sync(); }
#define NREP(k) (1 + ((PROBE_DUP >> (k)) & 1))
#define PHASE(k, ...) if (lo <= (k) && (k) < hi) { __VA_ARGS__ if (NREP(k) == 2) { xcd_barrier(bar); __VA_ARGS__ } }
#define SEAM(k) do { if (lo <= (k) && (k) + 1 < hi) xcd_barrier(bar); } while (0)

    PHASE(0, { p0_prologue(X); }) SEAM(0);
    PHASE(1, { p_modulate(X, args.in[I_X], mod, 0, U, U8); }) SEAM(1);
    PHASE(2, { { pg8::Gemm g{U, W1IN, M_TOK, FIN_BF_TILES * 256, DM, DM}; pg8::StaticOrder S; S.init(M_TOK, FIN_BF_TILES * 256, X.G, X.bx); pg8::EpiSwiglu<false> E{ACT};
          pg8::gemm_phase<pg8::EpiSwiglu<false>, pg8::StaticOrder, true>(X.lds, g, S, E); }
        { pg8::Gemm g{(const bf16_t*)U8, (const bf16_t*)(ws + WS_W1IN8), M_TOK, (44 - FIN_BF_TILES) * 256, DM, DM}; pg8::StaticOrder S; S.init(M_TOK, (44 - FIN_BF_TILES) * 256, X.G, X.bx); pg8::EpiSwiglu<true> E{ACT};
          pg8::gemm_phase<pg8::EpiSwiglu<true>, pg8::StaticOrder, false, true>(X.lds, g, S, E); } }) SEAM(2);
    PHASE(3, { pg8::Gemm g{ACT, W1OUT, M_TOK, DM, DFF, DFF}; pg8::StaticOrder S; S.init(M_TOK, DM, X.G, X.bx); pg8::EpiResidT<false> E{args.in[I_X], R, mod + 2 * DM, 0.5f, nullptr, nullptr, nullptr};
        pg8::gemm_phase<pg8::EpiResidT<false>, pg8::StaticOrder, ALIGN2>(X.lds, g, S, E); }) SEAM(3);
    PHASE(4, { p_layernorm<false, true>(X, R, args.in[I_LN1G], args.in[I_LN1B], nullptr, STATS, mod, 3 * DM, U, U8); }) SEAM(4);
    PHASE(5, { { pg8::Gemm g{U, WMIX, M_TOK, 6144, DM, DM}; pg8::StaticOrder S; S.init(M_TOK, 6144, X.G, X.bx); pg8::EpiMix E{MIX, GATES};
          pg8::gemm_phase<pg8::EpiMix, pg8::StaticOrder, true>(X.lds, g, S, E); }
        { pg8::Gemm g{(const bf16_t*)U8, (const bf16_t*)(ws + WS_WG8), M_TOK, 4096, DM, DM}; pg8::StaticOrder S; S.init(M_TOK, 4096, X.G, X.bx); pg8::EpiGates8 E{GATES};
          pg8::gemm_phase<pg8::EpiGates8, pg8::StaticOrder, true, true>(X.lds, g, S, E); } }) SEAM(5);
    PHASE(6, {
        p_gla_chunk(X, U, WLR, MIX, DEC, UB, args.in[I_WA2], args.in[I_BAL]);
        LAS float* bt = (LAS float*)(X.lds + L_ABIAS);
        for (int i = X.tid; i < 16 * 320; i += 512) bt[i] = args.in[I_RELB][i] * LOG2E;
        __syncthreads();
        for (int uid = X.bx * 8 + X.wave; uid < 8192; uid += X.G * 8) { const int half = uid & 1, n = (uid >> 1) & 63, bh = uid >> 7; attn_unit(X, MIX, bh >> 4, bh & 15, n, half); }
    }) SEAM(6);
    PHASE(7, { p_gla_scan_elem(X, DEC, UB, ST); }) SEAM(7);
    PHASE(8, { p_gla_readout(X, MIX, ST, args.in[I_GNG]); }) SEAM(8);
    PHASE(9, { pg8::Gemm g{MIX + C_QA, WPA, M_TOK, DM, 1024, MIXP}; pg8::StaticOrder S; S.init(M_TOK, DM, X.G, X.bx); pg8::EpiGate<false> E{GATES, U, nullptr};
        pg8::gemm_phase<pg8::EpiGate<false>, pg8::StaticOrder, true>(X.lds, g, S, E); asm volatile("s_waitcnt vmcnt(0)" ::: "memory"); __syncthreads(); })
    PHASE(10, { pg8::Gemm g{MIX + C_RB, WPB, M_TOK, DM, 1024, MIXP}; pg8::StaticOrder S; S.init(M_TOK, DM, X.G, X.bx); pg8::EpiGate<true> E{GATES + 2048, U, MIX + C_MERGED};
        pg8::gemm_phase<pg8::EpiGate<true>, pg8::StaticOrder, true>(X.lds, g, S, E); }) SEAM(10);
    PHASE(11, { pg8::Gemm g{MIX + C_MERGED, WMO, M_TOK, DM, DM, MIXP}; pg8::StaticOrder S; S.init(M_TOK, DM, X.G, X.bx); pg8::EpiResidT<true> E{R, R, mod + 5 * DM, 1.0f, STATS, args.in[I_LN1G], args.in[I_LN1B]};
        pg8::gemm_phase<pg8::EpiResidT<true>, pg8::StaticOrder, ALIGN2>(X.lds, g, S, E); }) SEAM(11);
    PHASE(12, { p_layernorm<false, true>(X, R, args.in[I_LN2G], args.in[I_LN2B], nullptr, STATS, mod, 6 * DM, U, U8); }) SEAM(12);
    PHASE(13, { { pg8::Gemm g{U, W2IN, M_TOK, FIN_BF_TILES * 256, DM, DM}; pg8::StaticOrder S; S.init(M_TOK, FIN_BF_TILES * 256, X.G, X.bx); pg8::EpiSwiglu<false> E{ACT};
          pg8::gemm_phase<pg8::EpiSwiglu<false>, pg8::StaticOrder, true>(X.lds, g, S, E); }
        { pg8::Gemm g{(const bf16_t*)U8, (const bf16_t*)(ws + WS_W2IN8), M_TOK, (44 - FIN_BF_TILES) * 256, DM, DM}; pg8::StaticOrder S; S.init(M_TOK, (44 - FIN_BF_TILES) * 256, X.G, X.bx); pg8::EpiSwiglu<true> E{ACT};
          pg8::gemm_phase<pg8::EpiSwiglu<true>, pg8::StaticOrder, false, true>(X.lds, g, S, E); } }) SEAM(13);
    PHASE(14, { pg8::Gemm g{ACT, W2OUT, M_TOK, DM, DFF, DFF}; pg8::StaticOrder S; S.init(M_TOK, DM, X.G, X.bx); pg8::EpiResidT<true> E{R, R, mod + 8 * DM, 0.5f, STATS, args.in[I_LN2G], args.in[I_LN2B]};
        pg8::gemm_phase<pg8::EpiResidT<true>, pg8::StaticOrder, ALIGN2>(X.lds, g, S, E); }) SEAM(14);
    PHASE(15, { p_layernorm<true>(X, R, args.in[I_LN3G], args.in[I_LN3B], R, nullptr, nullptr, 0, nullptr); })
#undef PHASE
#undef SEAM
}

constexpr int N_PHASES = 16;

extern "C" void kernel_launch(void* const* d_in, const int* in_sizes, int n_in, void* d_out, int out_size, void* d_ws, size_t ws_size, hipStream_t stream) {
    static int grid = 0;
    if (grid == 0) {
        if (n_in != 22 || out_size != M_TOK * DM || ws_size < WS_END) { fprintf(stderr, "kernel_launch: unexpected shapes (n_in %d, out %d, ws %zu < %zu)\n", n_in, out_size, ws_size, (size_t)WS_END); grid = -1; return; }
        int dev = 0, cus = 0, per_cu = 0;
        (void)hipGetDevice(&dev); (void)hipDeviceGetAttribute(&cus, hipDeviceAttributeMultiprocessorCount, dev);
        if (hipFuncSetAttribute((const void*)fwd_megakernel, hipFuncAttributeMaxDynamicSharedMemorySize, LDS_BYTES) != hipSuccess) { fprintf(stderr, "kernel_launch: hipFuncSetAttribute failed\n"); grid = -1; return; }
        if (hipOccupancyMaxActiveBlocksPerMultiprocessor(&per_cu, (const void*)fwd_megakernel, 512, LDS_BYTES) != hipSuccess || per_cu < 1) { fprintf(stderr, "kernel_launch: occupancy query says %d\n", per_cu); per_cu = 1; }
        (void)hipGetLastError();
        grid = cus > 0 ? cus : 256;
    }
    if (grid < 0) return;
    if (hipMemsetAsync((char*)d_ws + WS_BAR, 0, BAR_BYTES, stream) != hipSuccess) { fprintf(stderr, "kernel_launch: memset of the barrier words failed\n"); return; }
    Args a{};
    for (int i = 0; i < 22; ++i) a.in[i] = (const float*)d_in[i];
    a.out = (float*)d_out; a.ws = (unsigned char*)d_ws;
#if MK_COOP
    a.ph_lo = 0; a.ph_hi = N_PHASES;
    void* kargs[] = {&a};
    hipError_t e = hipLaunchCooperativeKernel((const void*)fwd_megakernel, dim3(grid), dim3(512), kargs, LDS_BYTES, stream);
    if (e != hipSuccess) fprintf(stderr, "kernel_launch: cooperative launch failed: %s (grid %d)\n", hipGetErrorString(e), grid);
#else
    for (int ph = 0; ph < N_PHASES; ++ph) { a.ph_lo = ph; a.ph_hi = ph + 1; hipLaunchKernelGGL(fwd_megakernel, dim3(grid), dim3(512), LDS_BYTES, stream, a); }
#endif
}
```

```cpp
#include <hip/hip_runtime.h>
#include <hip/hip_cooperative_groups.h>
#include <cstdio>
#include <cstdint>
namespace cg = cooperative_groups;

#ifndef MK_COOP
#define MK_COOP 1
#endif

#ifndef ALIGN2
#define ALIGN2 false
#endif
#ifndef PROBE_DUP
#define PROBE_DUP 0
#endif

#define LAS __attribute__((address_space(3)))
typedef unsigned short bf16_t;
typedef short bf16x8 __attribute__((ext_vector_type(8)));
typedef float f32x4 __attribute__((ext_vector_type(4)));
typedef float f32x16 __attribute__((ext_vector_type(16)));
typedef unsigned u32x4 __attribute__((ext_vector_type(4)));
typedef unsigned u32x2 __attribute__((ext_vector_type(2)));
typedef short s16x4 __attribute__((ext_vector_type(4)));
typedef int i32x4 __attribute__((ext_vector_type(4)));
typedef int i32x8 __attribute__((ext_vector_type(8)));
constexpr int FIN_BF_TILES = 36;
constexpr float G8_SCALE = 64.f;

constexpr int M_TOK = 16384, DM = 2048, DFF = 5632, SEQ = 4096, NMOD = 18432;
constexpr int MIXP = 6144;
constexpr int GP = 4096;
constexpr int C_QA = 0, C_KA = 1024, C_VA = 2048, C_QB = 3072, C_KB = 3584, C_VB = 4096, C_RB = 5120, C_MERGED = 1024;
constexpr int WMIX_SRC_LD = 10256;
constexpr float ALPHA = 1.189207115002721f;
constexpr float LN_EPS = 1e-5f, RMS_EPS = 1e-6f;
constexpr float LOG2E = 1.4426950408889634f;

constexpr size_t MiB = 1u << 20;
constexpr size_t WS_BAR = 320 * 1024, BAR_BYTES = 16384;
constexpr size_t WS_STAT = 336 * 1024;
constexpr size_t WS_MOD = 4096;
constexpr size_t WS_DEC = 512 * 1024;
constexpr size_t WS_W1IN = 1 * MiB, WS_W1OUT = 45 * MiB, WS_WMIX = 67 * MiB, WS_WLR = 107 * MiB, WS_WPA = 108 * MiB, WS_WPB = 112 * MiB,
                 WS_WMO = 116 * MiB, WS_W2IN = 124 * MiB, WS_W2OUT = 168 * MiB, WS_U = 190 * MiB, WS_H = 254 * MiB, WS_BIG = 382 * MiB, WS_UB = 574 * MiB, WS_W1IN8 = 638 * MiB, WS_W2IN8 = 642 * MiB, WS_END = 646 * MiB;

constexpr size_t WS_WG8 = 91 * MiB;
constexpr int LDS_MISC = 147456 - 64;
constexpr int LDS_BYTES = 147456;

typedef float f32x2_t __attribute__((ext_vector_type(2))); typedef __bf16 bf16x2_t __attribute__((ext_vector_type(2)));
__device__ __forceinline__ unsigned cvt_pk_bf16(float lo, float hi) { const f32x2_t v = {lo, hi}; const bf16x2_t b = __builtin_convertvector(v, bf16x2_t); return __builtin_bit_cast(unsigned, b); }
__device__ __forceinline__ float bf_lo(unsigned w) { return __uint_as_float(w << 16); }
__device__ __forceinline__ float bf_hi(unsigned w) { return __uint_as_float(w & 0xffff0000u); }
__device__ __forceinline__ float fast_sigmoid(float x) { return __builtin_amdgcn_rcpf(1.f + __builtin_amdgcn_exp2f(-LOG2E * x)); }
__device__ __forceinline__ float fast_silu(float x) { return x * fast_sigmoid(x); }
__device__ __forceinline__ f32x2_t sigmoid_pk(f32x2_t x) { const f32x2_t t = x * (-LOG2E); f32x2_t e; e[0] = __builtin_amdgcn_exp2f(t[0]); e[1] = __builtin_amdgcn_exp2f(t[1]);
    const f32x2_t d = e + 1.0f; f32x2_t r; r[0] = __builtin_amdgcn_rcpf(d[0]); r[1] = __builtin_amdgcn_rcpf(d[1]); return r; }
template <bool F8> __device__ __forceinline__ f32x2_t sigmoid_sc_pk(f32x2_t x) { constexpr float k = F8 ? -LOG2E / 64.f : -LOG2E; const f32x2_t t = x * k; f32x2_t e; e[0] = __builtin_amdgcn_exp2f(t[0]); e[1] = __builtin_amdgcn_exp2f(t[1]);
    const f32x2_t d = e + 1.0f; f32x2_t r; r[0] = __builtin_amdgcn_rcpf(d[0]); r[1] = __builtin_amdgcn_rcpf(d[1]); return r; }
template <bool F8> __device__ __forceinline__ f32x4 swiglu_pk4(f32x4 a, f32x4 b) { const f32x2_t a0 = {a[0], a[1]}, a1 = {a[2], a[3]}, b0 = {b[0], b[1]}, b1 = {b[2], b[3]};
    constexpr float s2 = F8 ? 1.f / (64.f * 64.f) : 1.f;
    f32x2_t o0 = (a0 * b0) * sigmoid_sc_pk<F8>(a0), o1 = (a1 * b1) * sigmoid_sc_pk<F8>(a1); if constexpr (F8) { o0 = o0 * s2; o1 = o1 * s2; } return (f32x4){o0[0], o0[1], o1[0], o1[1]}; }
__device__ __forceinline__ f32x4 gate_pk4(f32x4 v, unsigned glo, unsigned ghi) {
    const f32x2_t g0 = {__uint_as_float(glo << 16), __uint_as_float(glo & 0xffff0000u)}, g1 = {__uint_as_float(ghi << 16), __uint_as_float(ghi & 0xffff0000u)};
    const f32x2_t v0 = {v[0], v[1]}, v1 = {v[2], v[3]}; const f32x2_t o0 = v0 * sigmoid_pk(g0), o1 = v1 * sigmoid_pk(g1); return (f32x4){o0[0], o0[1], o1[0], o1[1]}; }
__device__ __forceinline__ float wave_sum(float v) {
#pragma unroll
    for (int o = 1; o < 64; o <<= 1) v += __shfl_xor(v, o);
    return v;
}

namespace pg8 {
constexpr int BM = 256, BK = 64, HALF = 128, HTB = HALF * BK * 2, STAGE_BYTES = 8 * HTB, NXCD = 8, WGM = 8;
__host__ __device__ __forceinline__ int lds_byte(int r, int c) { const int st = (r >> 4) * 2 + (c >> 5), rr = r & 15, cc = c & 31, ob = rr * 64 + cc * 2; return st * 1024 + (ob ^ (((ob >> 9) & 1) << 5)); }
__host__ __device__ __forceinline__ void stage_rc(int b, int& R, int& C) { const int st = b / 1024, sb = b % 1024, swz = sb ^ (((sb >> 9) & 1) << 5); R = (st >> 1) * 16 + swz / 64; C = (st & 1) * 32 + (swz % 64) / 2; }
__host__ __device__ __forceinline__ int perm32(int rho) { const int n = rho >> 4, i = rho & 15; return 8 * (i >> 2) + 4 * n + (i & 3); }

struct Unit { int pm, pn; };
struct Gemm { const bf16_t* A; const bf16_t* Bt; int M, N, K, lda; };

struct StaticOrder {
    int nM, nN, nwg, G, c;
    __host__ __device__ void init(int M, int N, int G_, int c_) { nM = M / BM; nN = N / BM; nwg = nM * nN; G = G_; c = c_; }
    __host__ __device__ bool next(int i, Unit& u) const {
        const long L = (long)i * G + c; if (L >= nwg) return false;
        int wgid = (int)L; { const int q = nwg / NXCD, r = nwg % NXCD, xcd = wgid % NXCD, off = wgid / NXCD; wgid = (xcd < r ? xcd * (q + 1) : r * (q + 1) + (xcd - r) * q) + off; }
        const int nig = WGM * nN, gid = wgid / nig, fm = gid * WGM, gsz = (nM - fm) < WGM ? (nM - fm) : WGM;
        u.pm = fm + ((wgid % nig) % gsz); u.pn = (wgid % nig) / gsz; return true;
    }
};

template <class Epi, class Sched, bool ALIGN_EPI, bool FP8 = false>
__device__ __forceinline__ void gemm_phase(LAS unsigned char* lds, const Gemm g, const Sched& S, const Epi& E) {
    int tid_ = threadIdx.x; asm volatile("" : "+v"(tid_));
    const int tid = tid_, wid = __builtin_amdgcn_readfirstlane(tid >> 6), lane = tid & 63, wr = wid >> 2, wc = wid & 3, fr = lane & 15, fq = lane >> 4;
    const int K = g.K, nt = FP8 ? K / 128 : K / BK, lda = g.lda;
    const int pitchA = FP8 ? lda : lda * 2, pitchB = FP8 ? K : K * 2;
    unsigned voffA[2], voffB[2];
#pragma unroll
    for (int i = 0; i < 2; ++i) { int R, C; stage_rc(tid * 16 + i * 8192, R, C); const int Rb = Epi::PERM ? ((R & ~31) + perm32(R & 31)) : R;
        voffA[i] = (unsigned)(R * pitchA + C * 2); voffB[i] = (unsigned)(Rb * pitchB + C * 2); }
    const size_t kstep = (size_t)(BK * 2);
    const size_t hstepA = (size_t)HALF * pitchA, hstepB = (size_t)HALF * pitchB;
    const size_t tstepA = 2 * hstepA, tstepB = 2 * hstepB;
    const unsigned ldsw = (unsigned)wid * 1024u;
    const int aoff = lds_byte(wr * 64 + fr, fq * 8), boff = lds_byte(wc * 32 + fr, fq * 8);
#define PG8_SA(b, h) (((b) * 2 + (h)) * HTB)
#define PG8_SB(b, h) ((4 + (b) * 2 + (h)) * HTB)
#define PG8_STAGE(bufoff, gbase, voff) do { _Pragma("unroll") for (int _i = 0; _i < 2; ++_i) \
        __builtin_amdgcn_global_load_lds((const unsigned*)((const char*)(gbase) + (voff)[_i]), (LAS unsigned*)(lds + (bufoff) + ldsw + _i * 8192), 16, 0, 0); } while (0)
#define PG8_LD8(off) __builtin_shufflevector(*(const LAS i32x4*)(lds + (off)), *(const LAS i32x4*)(lds + (off) + 1024), 0, 1, 2, 3, 4, 5, 6, 7)
#define PG8_LDA(dst, b, h) do { if constexpr (FP8) { _Pragma("unroll") for (int m = 0; m < 4; ++m) dst##8[m] = PG8_LD8(PG8_SA(b, h) + aoff + m * 2048); } \
        else { _Pragma("unroll") for (int m = 0; m < 4; ++m) _Pragma("unroll") for (int k = 0; k < 2; ++k) dst[m][k] = *(const LAS bf16x8*)(lds + PG8_SA(b, h) + aoff + m * 2048 + k * 1024); } } while (0)
#define PG8_LDB(dst, b, h) do { if constexpr (FP8) { _Pragma("unroll") for (int n = 0; n < 2; ++n) dst##8[n] = PG8_LD8(PG8_SB(b, h) + boff + n * 2048); } \
        else { _Pragma("unroll") for (int n = 0; n < 2; ++n) _Pragma("unroll") for (int k = 0; k < 2; ++k) dst[n][k] = *(const LAS bf16x8*)(lds + PG8_SB(b, h) + boff + n * 2048 + k * 1024); } } while (0)
#define PG8_CAT8(x) __builtin_shufflevector(__builtin_bit_cast(i32x4, (x)[0]), __builtin_bit_cast(i32x4, (x)[1]), 0, 1, 2, 3, 4, 5, 6, 7)
#define PG8_MMA(ai, bj, At, Bt) do { __builtin_amdgcn_s_setprio(1); \
        if constexpr (FP8) { _Pragma("unroll") for (int m = 0; m < 4; ++m) _Pragma("unroll") for (int n = 0; n < 2; ++n) \
            asm volatile("v_mfma_f32_16x16x128_f8f6f4 %0, %1, %2, %0" : "+v"(acc[ai][bj][m][n]) : "v"(Bt##8[n]), "v"(At##8[m])); } \
        else { _Pragma("unroll") for (int m = 0; m < 4; ++m) _Pragma("unroll") for (int n = 0; n < 2; ++n) _Pragma("unroll") for (int k = 0; k < 2; ++k) \
            acc[ai][bj][m][n] = __builtin_amdgcn_mfma_f32_16x16x32_bf16(Bt[n][k], At[m][k], acc[ai][bj][m][n], 0, 0, 0); } \
        __builtin_amdgcn_s_setprio(0); } while (0)
#define PG8_WAIT_V(n) asm volatile("s_waitcnt vmcnt(" #n ")" ::: "memory")
#define PG8_WAIT_L(n) asm volatile("s_waitcnt lgkmcnt(" #n ")" ::: "memory")
#define PG8_BAR __builtin_amdgcn_s_barrier()
#define PG8_SCHED __builtin_amdgcn_sched_barrier(0)
    Unit cur, nxt; int ui = 0;
    if (!S.next(0, cur)) return;
    f32x4 acc[2][2][4][2];
#pragma unroll
    for (int a = 0; a < 2; ++a)
#pragma unroll
        for (int b = 0; b < 2; ++b)
#pragma unroll
            for (int m = 0; m < 4; ++m)
#pragma unroll
                for (int n = 0; n < 2; ++n) acc[a][b][m][n] = (f32x4){0.f, 0.f, 0.f, 0.f};
    bf16x8 At[4][2], B0[2][2], B1[2][2];
    i32x8 At8[4], B08[2], B18[2];
    const char* cA = (const char*)g.A + (size_t)cur.pm * tstepA; const char* cB = (const char*)g.Bt + (size_t)cur.pn * tstepB;
    PG8_STAGE(PG8_SB(0, 0), cB, voffB); PG8_STAGE(PG8_SB(0, 1), cB + hstepB, voffB); PG8_STAGE(PG8_SA(0, 0), cA, voffA); PG8_STAGE(PG8_SA(0, 1), cA + hstepA, voffA);
    if (wr == 1) PG8_BAR;
    PG8_WAIT_V(2); PG8_BAR;
    PG8_STAGE(PG8_SB(1, 0), cB + kstep, voffB); PG8_STAGE(PG8_SA(1, 0), cA + kstep, voffA); PG8_STAGE(PG8_SB(1, 1), cB + hstepB + kstep, voffB);
    PG8_WAIT_V(6); PG8_BAR;
    for (;;) {
        const bool has_next = S.next(ui + 1, nxt);
        const char* nA = has_next ? (const char*)g.A + (size_t)nxt.pm * tstepA : cA; const char* nB = has_next ? (const char*)g.Bt + (size_t)nxt.pn * tstepB : cB;
        for (int t = 0; t < nt; t += 2) {
            const bool last = (t == nt - 2);
            const char* a1 = cA + (size_t)(t + 1) * kstep;
            const char* a2 = last ? nA : cA + (size_t)(t + 2) * kstep; const char* b2 = last ? nB : cB + (size_t)(t + 2) * kstep;
            const char* a3 = a2 + kstep; const char* b3 = b2 + kstep;
            PG8_LDB(B0, 0, 0); PG8_LDB(B1, 0, 1); PG8_SCHED; PG8_LDA(At, 0, 0); PG8_STAGE(PG8_SA(1, 1), a1 + hstepA, voffA);
            PG8_WAIT_V(8); PG8_WAIT_L(0); PG8_BAR; PG8_MMA(0, 0, At, B0); PG8_MMA(0, 1, At, B1); PG8_BAR; PG8_SCHED;
            PG8_LDA(At, 0, 1); PG8_STAGE(PG8_SB(0, 0), b2, voffB); PG8_STAGE(PG8_SB(0, 1), b2 + hstepB, voffB); PG8_STAGE(PG8_SA(0, 0), a2, voffA);
            PG8_WAIT_V(8); PG8_WAIT_L(0); PG8_BAR; PG8_MMA(1, 0, At, B0); PG8_MMA(1, 1, At, B1); PG8_BAR; PG8_SCHED;
            PG8_LDB(B0, 1, 0); PG8_LDB(B1, 1, 1); PG8_SCHED; PG8_LDA(At, 1, 0); PG8_STAGE(PG8_SA(0, 1), a2 + hstepA, voffA);
            PG8_WAIT_V(8); PG8_WAIT_L(0); PG8_BAR; PG8_MMA(0, 0, At, B0); PG8_MMA(0, 1, At, B1); PG8_BAR; PG8_SCHED;
            PG8_LDA(At, 1, 1); PG8_STAGE(PG8_SB(1, 0), b3, voffB); PG8_STAGE(PG8_SB(1, 1), b3 + hstepB, voffB); PG8_STAGE(PG8_SA(1, 0), a3, voffA);
            PG8_WAIT_V(8); PG8_WAIT_L(0); PG8_BAR; PG8_MMA(1, 0, At, B0); PG8_MMA(1, 1, At, B1); PG8_BAR; PG8_SCHED;
        }
        if constexpr (ALIGN_EPI) { if (wr == 0) PG8_BAR; }
        E(acc, cur, wr, wc, fr, fq);
        if (!has_next) break;
#pragma unroll
        for (int a = 0; a < 2; ++a)
#pragma unroll
            for (int b = 0; b < 2; ++b)
#pragma unroll
                for (int m = 0; m < 4; ++m)
#pragma unroll
                    for (int n = 0; n < 2; ++n) acc[a][b][m][n] = (f32x4){0.f, 0.f, 0.f, 0.f};
        cur = nxt; cA = nA; cB = nB; ++ui;
        if constexpr (ALIGN_EPI) { if (wr == 1) PG8_BAR; }
    }
    PG8_WAIT_V(0);
    if constexpr (!ALIGN_EPI) { if (wr == 0) PG8_BAR; }
    PG8_BAR;
#undef PG8_SA
#undef PG8_SB
#undef PG8_STAGE
#undef PG8_LDA
#undef PG8_LD8
#undef PG8_LDB
#undef PG8_MMA
#undef PG8_CAT8
#undef PG8_WAIT_V
#undef PG8_WAIT_L
#undef PG8_BAR
#undef PG8_SCHED
}

typedef const f32x4 (&AccRef)[2][2][4][2];
__device__ __forceinline__ u32x4 pack8(f32x4 v0, f32x4 v1) { u32x4 w; w.x = cvt_pk_bf16(v0[0], v0[1]); w.y = cvt_pk_bf16(v0[2], v0[3]); w.z = cvt_pk_bf16(v1[0], v1[1]); w.w = cvt_pk_bf16(v1[2], v1[3]); return w; }

template <bool F8> struct EpiSwiglu {
    static constexpr bool PERM = true;
    bf16_t* O;
    __device__ __forceinline__ void operator()(AccRef acc, const Unit& u, int wr, int wc, int fr, int fq) const {
        constexpr int col_base = F8 ? FIN_BF_TILES * 128 : 0; constexpr float sc = F8 ? 1.f / G8_SCALE : 1.f;
        const int row0 = u.pm * BM + wr * 64 + fr, col0 = col_base + u.pn * HALF + wc * 32 + 8 * fq;
#pragma unroll
        for (int ai = 0; ai < 2; ++ai)
#pragma unroll
            for (int m = 0; m < 4; ++m) {
                bf16_t* p = O + (size_t)(row0 + ai * HALF + m * 16) * DFF + col0;
                const f32x4 v0 = swiglu_pk4<F8>(acc[ai][0][m][0], acc[ai][1][m][0]), v1 = swiglu_pk4<F8>(acc[ai][0][m][1], acc[ai][1][m][1]);
                *(u32x4*)p = pack8(v0, v1);
                if constexpr (F8) asm volatile("" ::: "memory");
            }
    }
};
template <bool LN> struct EpiResidT {
    static constexpr bool PERM = false;
    const float* hin; float* R; const float* gate; float gs; const float* stats; const float* lng; const float* lnb;
    __device__ __forceinline__ void operator()(AccRef acc, const Unit& u, int wr, int wc, int fr, int fq) const {
        const int row0 = u.pm * BM + wr * 64 + fr, col0 = u.pn * BM + wc * 32 + 4 * fq;
        const float* gp = gate + (size_t)(u.pm >> 4) * NMOD + col0;
        f32x2_t st[2][4];
#pragma unroll
        for (int ai = 0; ai < 2; ++ai)
#pragma unroll
            for (int m = 0; m < 4; ++m) { if constexpr (LN) st[ai][m] = *(const f32x2_t*)(stats + 2 * (size_t)(row0 + ai * HALF + m * 16)); else st[ai][m] = (f32x2_t){0.f, 1.f}; }
#pragma unroll
        for (int bj = 0; bj < 2; ++bj)
#pragma unroll
            for (int n = 0; n < 2; ++n) {
                const int co = bj * HALF + 16 * n;
                const f32x4 gv = *(const f32x4*)(gp + co) * gs;
                f32x4 lg4 = (f32x4){1.f, 1.f, 1.f, 1.f}, lb4 = (f32x4){0.f, 0.f, 0.f, 0.f};
                if constexpr (LN) { lg4 = *(const f32x4*)(lng + col0 + co); lb4 = *(const f32x4*)(lnb + col0 + co); }
                f32x4 hv[2][4];
#pragma unroll
                for (int ai = 0; ai < 2; ++ai)
#pragma unroll
                    for (int m = 0; m < 4; ++m) hv[ai][m] = *(const f32x4*)(hin + (size_t)(row0 + ai * HALF + m * 16) * DM + col0 + co);
#pragma unroll
                for (int ai = 0; ai < 2; ++ai)
#pragma unroll
                    for (int m = 0; m < 4; ++m) { const size_t off = (size_t)(row0 + ai * HALF + m * 16) * DM + col0 + co;
                        f32x4 h = hv[ai][m];
                        if constexpr (LN) h = (h - st[ai][m][0]) * st[ai][m][1] * lg4 + lb4;
                        *(f32x4*)(R + off) = h * ALPHA + gv * acc[ai][bj][m][n]; }
            }
    }
};
struct EpiMix {
    static constexpr bool PERM = true;
    bf16_t* MIX; bf16_t* GATES;
    __device__ __forceinline__ void operator()(AccRef acc, const Unit& u, int wr, int wc, int fr, int fq) const {
        const int row0 = u.pm * BM + wr * 64 + fr; int colt = u.pn * BM; bf16_t* base = MIX; int ldc = MIXP;
        if (colt >= 6144) { base = GATES; ldc = GP; colt -= 6144; }
        const int col0 = colt + wc * 32 + 8 * fq;
#pragma unroll
        for (int ai = 0; ai < 2; ++ai)
#pragma unroll
            for (int m = 0; m < 4; ++m) { bf16_t* p = base + (size_t)(row0 + ai * HALF + m * 16) * ldc + col0;
#pragma unroll
                for (int bj = 0; bj < 2; ++bj) *(u32x4*)(p + bj * HALF) = pack8(acc[ai][bj][m][0], acc[ai][bj][m][1]); }
    }
};
struct EpiGates8 {
    static constexpr bool PERM = true;
    bf16_t* GATES;
    __device__ __forceinline__ void operator()(AccRef acc, const Unit& u, int wr, int wc, int fr, int fq) const {
        const int row0 = u.pm * BM + wr * 64 + fr, col0 = u.pn * BM + wc * 32 + 8 * fq; const float sc = 1.f / G8_SCALE;
#pragma unroll
        for (int ai = 0; ai < 2; ++ai)
#pragma unroll
            for (int m = 0; m < 4; ++m) { bf16_t* p = GATES + (size_t)(row0 + ai * HALF + m * 16) * GP + col0;
#pragma unroll
                for (int bj = 0; bj < 2; ++bj) *(u32x4*)(p + bj * HALF) = pack8(acc[ai][bj][m][0] * sc, acc[ai][bj][m][1] * sc); }
    }
};
template <bool SECOND> struct EpiGate {
    static constexpr bool PERM = true;
    const bf16_t* G;
    bf16_t* T;
    bf16_t* OUT;
    __device__ __forceinline__ void operator()(AccRef acc, const Unit& u, int wr, int wc, int fr, int fq) const {
        const int row0 = u.pm * BM + wr * 64 + fr, col0 = u.pn * BM + wc * 32 + 8 * fq;
#pragma unroll
        for (int ai = 0; ai < 2; ++ai)
#pragma unroll
            for (int bj = 0; bj < 2; ++bj) {
                u32x4 gw[4], tw[4];
#pragma unroll
                for (int m = 0; m < 4; ++m) { const size_t row = (size_t)(row0 + ai * HALF + m * 16);
                    gw[m] = *(const u32x4*)(G + row * GP + col0 + bj * HALF);
                    if constexpr (SECOND) tw[m] = *(const u32x4*)(T + row * DM + col0 + bj * HALF); }
#pragma unroll
                for (int m = 0; m < 4; ++m) { const size_t row = (size_t)(row0 + ai * HALF + m * 16);
                    f32x4 v0 = gate_pk4(acc[ai][bj][m][0], gw[m].x, gw[m].y), v1 = gate_pk4(acc[ai][bj][m][1], gw[m].z, gw[m].w);
                    if constexpr (SECOND) {
                        v0[0] += bf_lo(tw[m].x); v0[1] += bf_hi(tw[m].x); v0[2] += bf_lo(tw[m].y); v0[3] += bf_hi(tw[m].y);
                        v1[0] += bf_lo(tw[m].z); v1[1] += bf_hi(tw[m].z); v1[2] += bf_lo(tw[m].w); v1[3] += bf_hi(tw[m].w);
                        *(u32x4*)(OUT + row * MIXP + col0 + bj * HALF) = pack8(v0, v1);
                    } else {
                        *(u32x4*)(T + row * DM + col0 + bj * HALF) = pack8(v0, v1);
                    }
                }
            }
    }
};
}

struct Args { const float* in[22]; float* out; unsigned char* ws; int ph_lo, ph_hi; };
enum { I_X = 0, I_C, I_WADA, I_BADA, I_F1IN, I_F1OUT, I_LN1G, I_LN1B, I_WMIX, I_RELB, I_WA2, I_BAL, I_GNG, I_WPA, I_WPB, I_WMO, I_LN2G, I_LN2B, I_F2IN, I_F2OUT, I_LN3G, I_LN3B };

struct Ctx {
    LAS unsigned char* lds; int tid, lane, wave, G, bx;
    const Args* a;
};

__device__ __forceinline__ void tr_item(const float* W, int ldw, int K, int k0, int c0, bf16_t* WT, int r0, int ncols, LAS float* scr, int lane) {
    const int cl = lane & 31;
    float tv[32];
#pragma unroll
    for (int i = 0; i < 32; ++i) { const int kk = 2 * i + (lane >> 5); tv[i] = (cl < ncols) ? W[(size_t)(k0 + kk) * ldw + c0 + cl] : 0.f; }
#pragma unroll
    for (int i = 0; i < 32; ++i) { const int kk = 2 * i + (lane >> 5); scr[kk * 33 + cl] = tv[i]; }
    asm volatile("s_waitcnt lgkmcnt(0)" ::: "memory");
    const int c = lane & 7;
#pragma unroll
    for (int j = 0; j < 4; ++j) { const int n = (lane >> 3) + 8 * j; const LAS float* s = scr + (8 * c) * 33 + n;
        u32x4 o; o.x = cvt_pk_bf16(s[0 * 33], s[1 * 33]); o.y = cvt_pk_bf16(s[2 * 33], s[3 * 33]); o.z = cvt_pk_bf16(s[4 * 33], s[5 * 33]); o.w = cvt_pk_bf16(s[6 * 33], s[7 * 33]);
        if (n < ncols) *(u32x4*)(WT + (size_t)(r0 + n) * K + k0 + 8 * c) = o; }
    asm volatile("s_waitcnt lgkmcnt(0)" ::: "memory");
}

__device__ __forceinline__ unsigned pk4_fp8(float a, float b, float c, float d) { int w = 0; w = __builtin_amdgcn_cvt_pk_fp8_f32(a, b, w, false); w = __builtin_amdgcn_cvt_pk_fp8_f32(c, d, w, true); return (unsigned)w; }
__device__ __forceinline__ void tr_item8(const float* W, int ldw, int K, int k0, int c0, unsigned char* W8, int r0, LAS float* scr, int lane) {
    const int cl = lane & 31;
    float tv[32];
#pragma unroll
    for (int i = 0; i < 32; ++i) { const int kk = 2 * i + (lane >> 5); tv[i] = W[(size_t)(k0 + kk) * ldw + c0 + cl] * G8_SCALE; }
#pragma unroll
    for (int i = 0; i < 32; ++i) { const int kk = 2 * i + (lane >> 5); scr[kk * 33 + cl] = tv[i]; }
    asm volatile("s_waitcnt lgkmcnt(0)" ::: "memory");
    const int c = lane & 3;
#pragma unroll
    for (int j = 0; j < 2; ++j) { const int n = (lane >> 2) + 16 * j; const LAS float* s = scr + (16 * c) * 33 + n;
        u32x4 o; o.x = pk4_fp8(s[0 * 33], s[1 * 33], s[2 * 33], s[3 * 33]); o.y = pk4_fp8(s[4 * 33], s[5 * 33], s[6 * 33], s[7 * 33]);
        o.z = pk4_fp8(s[8 * 33], s[9 * 33], s[10 * 33], s[11 * 33]); o.w = pk4_fp8(s[12 * 33], s[13 * 33], s[14 * 33], s[15 * 33]);
        *(u32x4*)(W8 + (size_t)(r0 + n) * K + k0 + 16 * c) = o; }
    asm volatile("s_waitcnt lgkmcnt(0)" ::: "memory");
}

__device__ __forceinline__ void p0_prologue(const Ctx& X) {
    const Args& a = *X.a; unsigned char* ws = a.ws;
    LAS float* sl = (LAS float*)X.lds;
    LAS float* red = (LAS float*)(X.lds + 32768);
    for (int i = X.tid; i < 4 * DM; i += 512) sl[i] = fast_silu(a.in[I_C][i]);
    __syncthreads();
    float* mod = (float*)(ws + WS_MOD);
    for (int it = X.bx; it < NMOD / 64; it += X.G) {
        const int j0 = it * 64; const float* wp = a.in[I_WADA] + (size_t)(256 * X.wave) * NMOD + j0 + X.lane;
        float a0 = 0.f, a1 = 0.f, a2 = 0.f, a3 = 0.f;
        for (int k8 = 0; k8 < 256; k8 += 32) { float wv[32];
#pragma unroll
            for (int q = 0; q < 32; ++q) wv[q] = wp[(size_t)(k8 + q) * NMOD];
#pragma unroll
            for (int q = 0; q < 32; ++q) { const int k = 256 * X.wave + k8 + q; a0 += sl[k] * wv[q]; a1 += sl[DM + k] * wv[q]; a2 += sl[2 * DM + k] * wv[q]; a3 += sl[3 * DM + k] * wv[q]; } }
        red[(X.wave * 4 + 0) * 64 + X.lane] = a0; red[(X.wave * 4 + 1) * 64 + X.lane] = a1; red[(X.wave * 4 + 2) * 64 + X.lane] = a2; red[(X.wave * 4 + 3) * 64 + X.lane] = a3;
        __syncthreads();
        if (X.tid < 256) { const int b = X.tid >> 6, l = X.tid & 63; float s = a.in[I_BADA][j0 + l];
#pragma unroll
            for (int w = 0; w < 8; ++w) s += red[(w * 4 + b) * 64 + l];
            mod[(size_t)b * NMOD + j0 + l] = s; }
        __syncthreads();
    }
    __syncthreads();
    LAS float* scr = (LAS float*)(X.lds + X.wave * 16384);
    const int gw = X.bx * 8 + X.wave, NGW = X.G * 8;
    constexpr int I_FIN = 32 * 352, I_FOUT = 88 * 64, I_MIX = 32 * 320, I_LR = 32, I_P = 16 * 64, I_MO = 32 * 64;
    constexpr int NITEMS = 2 * I_FIN + 2 * I_FOUT + I_MIX + I_LR + 2 * I_P + I_MO;
    for (int it = gw; it < NITEMS; it += NGW) {
        int r = it;
        if (r < 2 * I_FIN) { const int which = r >= I_FIN; r -= which * I_FIN; const int kb = r / 352, nb = r % 352, c0 = 32 * nb, bj = c0 / DFF, j = c0 % DFF;
            const int rd = 256 * (j / 128) + 128 * bj + (j % 128);
            if (rd < FIN_BF_TILES * 256) tr_item(a.in[which ? I_F2IN : I_F1IN], 2 * DFF, DM, 64 * kb, c0, (bf16_t*)(ws + (which ? WS_W2IN : WS_W1IN)), rd, 32, scr, X.lane);
            else tr_item8(a.in[which ? I_F2IN : I_F1IN], 2 * DFF, DM, 64 * kb, c0, ws + (which ? WS_W2IN8 : WS_W1IN8), rd - FIN_BF_TILES * 256, scr, X.lane);
            continue; }
        r -= 2 * I_FIN;
        if (r < 2 * I_FOUT) { const int which = r >= I_FOUT; r -= which * I_FOUT; const int kb = r / 64, nb = r % 64;
            tr_item(a.in[which ? I_F2OUT : I_F1OUT], DM, DFF, 64 * kb, 32 * nb, (bf16_t*)(ws + (which ? WS_W2OUT : WS_W1OUT)), 32 * nb, 32, scr, X.lane); continue; }
        r -= 2 * I_FOUT;
        if (r < I_MIX) { const int kb = r / 320, nb = r % 320, r0 = 32 * nb, c0 = r0 < 6144 ? r0 : r0 + 16;
            if (r0 < 6144) tr_item(a.in[I_WMIX], WMIX_SRC_LD, DM, 64 * kb, c0, (bf16_t*)(ws + WS_WMIX), r0, 32, scr, X.lane);
            else tr_item8(a.in[I_WMIX], WMIX_SRC_LD, DM, 64 * kb, c0, ws + WS_WG8, r0 - 6144, scr, X.lane);
            continue; }
        r -= I_MIX;
        if (r < I_LR) { tr_item(a.in[I_WMIX], WMIX_SRC_LD, DM, 64 * r, 6144, (bf16_t*)(ws + WS_WLR), 0, 16, scr, X.lane); continue; }
        r -= I_LR;
        if (r < 2 * I_P) { const int which = r >= I_P; r -= which * I_P; const int kb = r / 64, nb = r % 64;
            tr_item(a.in[which ? I_WPB : I_WPA], DM, 1024, 64 * kb, 32 * nb, (bf16_t*)(ws + (which ? WS_WPB : WS_WPA)), 32 * nb, 32, scr, X.lane); continue; }
        r -= 2 * I_P;
        { const int kb = r / 64, nb = r % 64; tr_item(a.in[I_WMO], DM, DM, 64 * kb, 32 * nb, (bf16_t*)(ws + WS_WMO), 32 * nb, 32, scr, X.lane); }
    }
}

__device__ __forceinline__ void p_modulate(const Ctx& X, const float* x, const float* mod, int sh_off, bf16_t* U, unsigned char* U8) {
    const size_t n8 = (size_t)M_TOK * DM / 8;
    for (size_t i = (size_t)X.bx * 512 + X.tid; i < n8; i += (size_t)X.G * 512) {
        const int row = (int)(i >> 8), c8 = (int)(i & 255) * 8; const float* mp = mod + (size_t)(row >> 12) * NMOD + sh_off + c8;
        const f32x4 x0 = *(const f32x4*)(x + (size_t)row * DM + c8), x1 = *(const f32x4*)(x + (size_t)row * DM + c8 + 4);
        const f32x4 s0 = *(const f32x4*)(mp), s1 = *(const f32x4*)(mp + 4), c0 = *(const f32x4*)(mp + DM), c1 = *(const f32x4*)(mp + DM + 4);
        const f32x4 u0 = x0 * (1.f + c0) + s0, u1 = x1 * (1.f + c1) + s1;
        *(u32x4*)(U + (size_t)row * DM + c8) = pg8::pack8(u0, u1);
        u32x2 w8; w8.x = pk4_fp8(u0[0], u0[1], u0[2], u0[3]); w8.y = pk4_fp8(u1[0], u1[1], u1[2], u1[3]); *(u32x2*)(U8 + (size_t)row * DM + c8) = w8;
    }
}

template <bool LAST, bool F8 = false>
__device__ __forceinline__ void p_layernorm(const Ctx& X, const float* R, const float* lg, const float* lb, float* Hout, float* stats, const float* mod, int sh_off, bf16_t* U, unsigned char* U8 = nullptr) {
    const int gw = X.bx * 8 + X.wave, NGW = X.G * 8;
    for (int row = gw; row < M_TOK; row += NGW) {
        const float* rp = R + (size_t)row * DM + 4 * X.lane;
        f32x4 v[8]; float s = 0.f;
#pragma unroll
        for (int j = 0; j < 8; ++j) { v[j] = *(const f32x4*)(rp + 256 * j); s += (v[j][0] + v[j][1]) + (v[j][2] + v[j][3]); }
        const float mean = wave_sum(s) * (1.f / DM); float s2 = 0.f;
#pragma unroll
        for (int j = 0; j < 8; ++j) { v[j] = v[j] - mean; s2 += (v[j][0] * v[j][0] + v[j][1] * v[j][1]) + (v[j][2] * v[j][2] + v[j][3] * v[j][3]); }
        const float rstd = 1.f / sqrtf(wave_sum(s2) * (1.f / DM) + LN_EPS);
        const float* mp = LAST ? nullptr : mod + (size_t)(row >> 12) * NMOD + sh_off + 4 * X.lane;
        if constexpr (!LAST) { if (X.lane == 0) *(f32x2_t*)(stats + 2 * (size_t)row) = (f32x2_t){mean, rstd}; }
#pragma unroll
        for (int j = 0; j < 8; ++j) {
            const f32x4 g4 = *(const f32x4*)(lg + 4 * X.lane + 256 * j), b4 = *(const f32x4*)(lb + 4 * X.lane + 256 * j);
            const f32x4 y = v[j] * rstd * g4 + b4;
            if constexpr (LAST) *(f32x4*)(Hout + (size_t)row * DM + 4 * X.lane + 256 * j) = y;
            if constexpr (!LAST) { const f32x4 sh = *(const f32x4*)(mp + 256 * j), sc = *(const f32x4*)(mp + DM + 256 * j); const f32x4 uu = y * (1.f + sc) + sh;
                u32x2 w; w.x = cvt_pk_bf16(uu[0], uu[1]); w.y = cvt_pk_bf16(uu[2], uu[3]); *(u32x2*)(U + (size_t)row * DM + 4 * X.lane + 256 * j) = w;
                if constexpr (F8) *(unsigned*)(U8 + (size_t)row * DM + 4 * X.lane + 256 * j) = pk4_fp8(uu[0], uu[1], uu[2], uu[3]); }
        }
    }
}

__device__ __forceinline__ s16x4 tr_read(const LAS unsigned char* p) { return __builtin_bit_cast(s16x4, __builtin_amdgcn_ds_read_tr16_b64_v4i16((LAS s16x4*)p)); }
__device__ __forceinline__ bf16x8 cat8(s16x4 a, s16x4 b) { return (bf16x8){a[0], a[1], a[2], a[3], b[0], b[1], b[2], b[3]}; }

constexpr int KD_P = 1088, V_P = 576, OT_P = 528;
constexpr int L1_RED = 0, L1_LRS = 32768, L1_KD = 36864, L1_V = L1_KD + 64 * KD_P, L1_END = L1_V + 64 * V_P;
static_assert(L1_END <= 147456, "gla chunk LDS");

__device__ __forceinline__ void p_gla_chunk(const Ctx& X, const bf16_t* U, const bf16_t* WLR, const bf16_t* MIX, float* DEC, bf16_t* UB, const float* wa2, const float* bal) {
    LAS unsigned char* lds = X.lds;
    LAS float* red = (LAS float*)(lds + L1_RED);
    LAS float* lrs = (LAS float*)(lds + L1_LRS);
    const int tid = X.tid, lane = X.lane, w = X.wave, l15 = lane & 15, g = lane >> 4;
    const int tr_row = 8 * g + (l15 >> 2), tr_col = 4 * (l15 & 3);
    const int vr = tid >> 5, vc = tid & 31;
    for (int ch = X.bx; ch < 256; ch += X.G) {
        const size_t t0 = (size_t)ch * 64;
        f32x4 acc[4];
#pragma unroll
        for (int mi = 0; mi < 4; ++mi) acc[mi] = (f32x4){0.f, 0.f, 0.f, 0.f};
        const int kw = 256 * w + 8 * g;
#pragma unroll
        for (int s = 0; s < 8; ++s) {
            const bf16x8 bfr = *(const bf16x8*)(WLR + (size_t)l15 * DM + kw + 32 * s);
#pragma unroll
            for (int mi = 0; mi < 4; ++mi) { const bf16x8 afr = *(const bf16x8*)(U + (t0 + 16 * mi + l15) * DM + kw + 32 * s);
                acc[mi] = __builtin_amdgcn_mfma_f32_16x16x32_bf16(afr, bfr, acc[mi], 0, 0, 0); }
        }
#pragma unroll
        for (int mi = 0; mi < 4; ++mi)
#pragma unroll
            for (int e = 0; e < 4; ++e) red[(w * 64 + 16 * mi + 4 * g + e) * 16 + l15] = acc[mi][e];
        __syncthreads();
        for (int i = tid; i < 1024; i += 512) { float s = 0.f;
#pragma unroll
            for (int ww = 0; ww < 8; ++ww) s += red[ww * 1024 + i];
            lrs[i] = s; }
        __syncthreads();
        {   const int kp = tid;
            float wa[16];
#pragma unroll
            for (int r = 0; r < 16; ++r) wa[r] = wa2[r * 512 + kp];
            const float ba = bal[kp];
            float cum[64]; float run = 0.f;
#pragma unroll
            for (int c = 0; c < 64; ++c) {
                float z = ba;
#pragma unroll
                for (int r4 = 0; r4 < 4; ++r4) { const f32x4 l4 = *(const LAS f32x4*)(lrs + c * 16 + 4 * r4);
                    z += l4[0] * wa[4 * r4] + l4[1] * wa[4 * r4 + 1] + l4[2] * wa[4 * r4 + 2] + l4[3] * wa[4 * r4 + 3]; }
                const float ls = fminf(z, 0.f) - __logf(1.f + __expf(-fabsf(z)));
                run += ls * (1.f / 16.f); cum[c] = run;
            }
            DEC[(size_t)ch * 512 + kp] = __expf(run);
            const bf16_t* kptr = MIX + t0 * MIXP + C_KB + kp;
#pragma unroll
            for (int c = 0; c < 64; ++c) { const float kv = __uint_as_float((unsigned)kptr[(size_t)c * MIXP] << 16); const float kd = kv * __expf(run - cum[c]);
                *(LAS bf16_t*)(lds + L1_KD + c * KD_P + kp * 2) = (bf16_t)(cvt_pk_bf16(kd, 0.f) & 0xffffu); }
        }
        for (int h = 0; h < 4; ++h) {
            u32x4 pv[4];
#pragma unroll
            for (int i = 0; i < 4; ++i) pv[i] = *(const u32x4*)(MIX + (t0 + vr + 16 * i) * MIXP + C_VB + h * 256 + vc * 8);
            __syncthreads();
#pragma unroll
            for (int i = 0; i < 4; ++i) *(LAS u32x4*)(lds + L1_V + (vr + 16 * i) * V_P + vc * 16) = pv[i];
            __syncthreads();
            f32x4 uacc[2][8];
#pragma unroll
            for (int vt = 0; vt < 2; ++vt)
#pragma unroll
                for (int kt = 0; kt < 8; ++kt) uacc[vt][kt] = (f32x4){0.f, 0.f, 0.f, 0.f};
#pragma unroll
            for (int s = 0; s < 2; ++s) {
                bf16x8 va[2];
#pragma unroll
                for (int vt = 0; vt < 2; ++vt) { const LAS unsigned char* p = lds + L1_V + (32 * s + tr_row) * V_P + (32 * w + 16 * vt + tr_col) * 2; va[vt] = cat8(tr_read(p), tr_read(p + 4 * V_P)); }
#pragma unroll
                for (int kt = 0; kt < 8; ++kt) { const LAS unsigned char* p = lds + L1_KD + (32 * s + tr_row) * KD_P + (h * 128 + 16 * kt + tr_col) * 2;
                    const bf16x8 kf = cat8(tr_read(p), tr_read(p + 4 * KD_P));
                    uacc[0][kt] = __builtin_amdgcn_mfma_f32_16x16x32_bf16(va[0], kf, uacc[0][kt], 0, 0, 0);
                    uacc[1][kt] = __builtin_amdgcn_mfma_f32_16x16x32_bf16(va[1], kf, uacc[1][kt], 0, 0, 0); }
            }
            bf16_t* up = UB + ((size_t)(ch * 4 + h) * 128) * 256;
#pragma unroll
            for (int vt = 0; vt < 2; ++vt)
#pragma unroll
                for (int kt = 0; kt < 8; ++kt) { u32x2 o; o.x = cvt_pk_bf16(uacc[vt][kt][0], uacc[vt][kt][1]); o.y = cvt_pk_bf16(uacc[vt][kt][2], uacc[vt][kt][3]);
                    *(u32x2*)(up + (size_t)(16 * kt + l15) * 256 + 32 * w + 16 * vt + 4 * g) = o; }
        }
        __syncthreads();
    }
}

__device__ __forceinline__ void p_gla_scan_elem(const Ctx& X, const float* DEC, const bf16_t* UB, bf16_t* ST) {
    for (int idx = X.bx * 512 + X.tid; idx < 4 * 4 * 128 * 64; idx += X.G * 512) {
        const int vq = idx & 63, k = (idx >> 6) & 127, h = (idx >> 13) & 3, b = idx >> 15;
        const size_t off0 = ((size_t)((b * 64) * 4 + h) * 128 + k) * 256 + 4 * vq;
        const bf16_t* p0 = UB + off0; bf16_t* s0 = ST + off0;
        const float* d0 = DEC + (size_t)(b * 64) * 512 + h * 128 + k;
        f32x4 st = (f32x4){0.f, 0.f, 0.f, 0.f};
        for (int n8 = 0; n8 < 64; n8 += 8) {
            u32x2 uv[8]; float dv[8];
#pragma unroll
            for (int q = 0; q < 8; ++q) { uv[q] = *(const u32x2*)(p0 + (size_t)(n8 + q) * (4 * 128 * 256)); dv[q] = d0[(size_t)(n8 + q) * 512]; }
#pragma unroll
            for (int q = 0; q < 8; ++q) { const f32x4 uu = (f32x4){bf_lo(uv[q].x), bf_hi(uv[q].x), bf_lo(uv[q].y), bf_hi(uv[q].y)}; st = st * dv[q] + uu;
                u32x2 o; o.x = cvt_pk_bf16(st[0], st[1]); o.y = cvt_pk_bf16(st[2], st[3]); *(u32x2*)(s0 + (size_t)(n8 + q) * (4 * 128 * 256)) = o; }
        }
    }
}

constexpr int L3_S = 0, L3_SS = 128 * V_P, L3_OT = L3_SS + 2048, L3_END = L3_OT + 64 * OT_P;
static_assert(L3_END <= 131072, "gla readout LDS");
__device__ __forceinline__ void p_gla_readout(const Ctx& X, bf16_t* MIX, const bf16_t* UB, const float* gng) {
    LAS unsigned char* lds = X.lds;
    const int tid = X.tid, lane = X.lane, w = X.wave, l15 = lane & 15, g = lane >> 4;
    const int tr_row = 8 * g + (l15 >> 2), tr_col = 4 * (l15 & 3);
    const int vr = tid >> 5, vc = tid & 31;
    const float qscale = 0.08838834764831845f;
    for (int uid = X.bx; uid < 1024; uid += X.G) {
        const int ch = uid >> 2, h = uid & 3; const size_t t0 = (size_t)ch * 64;
        const bf16_t* sp = UB + ((size_t)(ch * 4 + h) * 128) * 256;
        u32x4 sv[8], rbv[4];
#pragma unroll
        for (int i = 0; i < 8; ++i) sv[i] = *(const u32x4*)(sp + (size_t)(vr + 16 * i) * 256 + vc * 8);
#pragma unroll
        for (int i = 0; i < 4; ++i) rbv[i] = *(const u32x4*)(MIX + (t0 + vr + 16 * i) * MIXP + C_RB + h * 256 + vc * 8);
        bf16x8 qf[4][4];
#pragma unroll
        for (int mc = 0; mc < 4; ++mc)
#pragma unroll
            for (int s = 0; s < 4; ++s) qf[mc][s] = *(const bf16x8*)(MIX + (t0 + 16 * mc + l15) * MIXP + C_QB + h * 128 + 32 * s + 8 * g);
#pragma unroll
        for (int i = 0; i < 8; ++i) *(LAS u32x4*)(lds + L3_S + (vr + 16 * i) * V_P + vc * 16) = sv[i];
        __syncthreads();
        f32x4 o[4][2];
#pragma unroll
        for (int mc = 0; mc < 4; ++mc) { o[mc][0] = (f32x4){0.f, 0.f, 0.f, 0.f}; o[mc][1] = (f32x4){0.f, 0.f, 0.f, 0.f}; }
#pragma unroll
        for (int s = 0; s < 4; ++s) {
            bf16x8 sb[2];
#pragma unroll
            for (int nt = 0; nt < 2; ++nt) { const LAS unsigned char* p = lds + L3_S + (32 * s + tr_row) * V_P + (32 * w + 16 * nt + tr_col) * 2; sb[nt] = cat8(tr_read(p), tr_read(p + 4 * V_P)); }
#pragma unroll
            for (int mc = 0; mc < 4; ++mc) { o[mc][0] = __builtin_amdgcn_mfma_f32_16x16x32_bf16(qf[mc][s], sb[0], o[mc][0], 0, 0, 0);
                o[mc][1] = __builtin_amdgcn_mfma_f32_16x16x32_bf16(qf[mc][s], sb[1], o[mc][1], 0, 0, 0); }
        }
#pragma unroll
        for (int mc = 0; mc < 4; ++mc) { f32x4 q2 = o[mc][0] * o[mc][0] + o[mc][1] * o[mc][1];
#pragma unroll
            for (int sh = 1; sh < 16; sh <<= 1) { q2[0] += __shfl_xor(q2[0], sh); q2[1] += __shfl_xor(q2[1], sh); q2[2] += __shfl_xor(q2[2], sh); q2[3] += __shfl_xor(q2[3], sh); }
            if (l15 == 0) *(LAS f32x4*)(lds + L3_SS + (w * 64 + 16 * mc + 4 * g) * 4) = q2; }
        __syncthreads();
#pragma unroll
        for (int mc = 0; mc < 4; ++mc) { f32x4 tot = (f32x4){0.f, 0.f, 0.f, 0.f};
#pragma unroll
            for (int ww = 0; ww < 8; ++ww) tot += *(const LAS f32x4*)(lds + L3_SS + (ww * 64 + 16 * mc + 4 * g) * 4);
#pragma unroll
            for (int e = 0; e < 4; ++e) { const float rs = qscale * __builtin_amdgcn_rsqf(tot[e] * (qscale * qscale / 256.f) + RMS_EPS);
#pragma unroll
                for (int nt = 0; nt < 2; ++nt) *(LAS bf16_t*)(lds + L3_OT + (16 * mc + 4 * g + e) * OT_P + (32 * w + 16 * nt + l15) * 2) = (bf16_t)(cvt_pk_bf16(o[mc][nt][e] * rs, 0.f) & 0xffffu); } }
        __syncthreads();
#pragma unroll
        for (int i = 0; i < 4; ++i) { const int row = vr + 16 * i; const u32x4 ot = *(const LAS u32x4*)(lds + L3_OT + row * OT_P + vc * 16);
            const f32x4 g0 = *(const f32x4*)(gng + vc * 8), g1 = *(const f32x4*)(gng + vc * 8 + 4); const u32x4 rb = rbv[i];
            f32x4 y0, y1;
            y0[0] = bf_lo(ot.x) * g0[0] * fast_silu(bf_lo(rb.x)); y0[1] = bf_hi(ot.x) * g0[1] * fast_silu(bf_hi(rb.x)); y0[2] = bf_lo(ot.y) * g0[2] * fast_silu(bf_lo(rb.y)); y0[3] = bf_hi(ot.y) * g0[3] * fast_silu(bf_hi(rb.y));
            y1[0] = bf_lo(ot.z) * g1[0] * fast_silu(bf_lo(rb.z)); y1[1] = bf_hi(ot.z) * g1[1] * fast_silu(bf_hi(rb.z)); y1[2] = bf_lo(ot.w) * g1[2] * fast_silu(bf_lo(rb.w)); y1[3] = bf_hi(ot.w) * g1[3] * fast_silu(bf_hi(rb.w));
            *(u32x4*)(MIX + (t0 + row) * MIXP + C_RB + h * 256 + vc * 8) = pg8::pack8(y0, y1); }
    }
}

__device__ __forceinline__ int crow(int r, int hi) { return (r & 3) + 8 * (r >> 2) + 4 * hi; }
constexpr int AV_P = 192, A_WAVE_BYTES = 64 * AV_P + 256, L_ABIAS = 8 * A_WAVE_BYTES;
static_assert(L_ABIAS + 16 * 320 * 4 <= 131072, "attention LDS");

__device__ __forceinline__ void attn_unit(const Ctx& X, bf16_t* MIX, int b, int h, int n, int half) {
    const int lane = X.lane, r32 = lane & 31, hi = lane >> 5;
    LAS unsigned char* wl = X.lds + X.wave * A_WAVE_BYTES;
    LAS float* wsf = (LAS float*)(wl + 64 * AV_P);
    const LAS float* bias2 = (const LAS float*)(X.lds + L_ABIAS) + h * 320;
    const size_t trow0 = (size_t)b * SEQ + n * 64 + half * 32;
    bf16x8 qr[4];
    { const bf16_t* Qp = MIX + (trow0 + r32) * MIXP + C_QA + h * 64 + hi * 8;
#pragma unroll
      for (int d0 = 0; d0 < 4; ++d0) qr[d0] = *(const bf16x8*)(Qp + d0 * 16); }
    f32x16 o0, o1;
#pragma unroll
    for (int r = 0; r < 16; ++r) { o0[r] = 0.f; o1[r] = 0.f; }
    float mrun = -1e30f, lrun = 0.f;
    const int vbase = (4 * hi + ((lane & 15) >> 2)) * AV_P + (16 * ((lane >> 4) & 1) + 4 * (lane & 3)) * 2;
    const float sc2 = 0.125f * LOG2E;
    const int j0 = (n >= 8 ? 0 : 8 - n);
    bf16x8 k0[4], k1[4]; u32x4 vv[8];
#define ATT_LOAD(j_) do { const size_t kv0_ = (size_t)b * SEQ + (size_t)(n - 8 + (j_)) * 64; \
        const bf16_t* Kp_ = MIX + (kv0_ + r32) * MIXP + C_KA + h * 64 + hi * 8; \
        _Pragma("unroll") for (int d0 = 0; d0 < 4; ++d0) { k0[d0] = *(const bf16x8*)(Kp_ + d0 * 16); k1[d0] = *(const bf16x8*)(Kp_ + (size_t)32 * MIXP + d0 * 16); } \
        const bf16_t* Vp_ = MIX + (kv0_ + (lane >> 3)) * MIXP + C_VA + h * 64 + (lane & 7) * 8; \
        _Pragma("unroll") for (int i = 0; i < 8; ++i) vv[i] = *(const u32x4*)(Vp_ + (size_t)(8 * i) * MIXP); } while (0)
    ATT_LOAD(j0);
    for (int j = j0; j < 9; ++j) {
#pragma unroll
        for (int i = 0; i < 8; ++i) *(LAS u32x4*)(wl + (8 * i + (lane >> 3)) * AV_P + (lane & 7) * 16) = vv[i];
        bf16x8 kc0[4], kc1[4];
#pragma unroll
        for (int d0 = 0; d0 < 4; ++d0) { kc0[d0] = k0[d0]; kc1[d0] = k1[d0]; }
        if (j + 1 < 9) ATT_LOAD(j + 1);
        f32x16 p0, p1;
#pragma unroll
        for (int r = 0; r < 16; ++r) { p0[r] = 0.f; p1[r] = 0.f; }
#pragma unroll
        for (int d0 = 0; d0 < 4; ++d0) { p0 = __builtin_amdgcn_mfma_f32_32x32x16_bf16(kc0[d0], qr[d0], p0, 0, 0, 0); p1 = __builtin_amdgcn_mfma_f32_32x32x16_bf16(kc1[d0], qr[d0], p1, 0, 0, 0); }
        if (j <= 3) { const float bc = bias2[0];
#pragma unroll
            for (int r = 0; r < 16; ++r) { p0[r] = p0[r] * sc2 + bc; p1[r] = p1[r] * sc2 + bc; }
        } else { const int rb = (j - 8) * 64 - (32 * half + r32) + 4 * hi + 256;
#pragma unroll
            for (int r = 0; r < 16; ++r) { const int c = (r & 3) + 8 * (r >> 2); const int i0 = max(rb + c, 0), i1 = max(rb + c + 32, 0);
                p0[r] = p0[r] * sc2 + bias2[i0]; p1[r] = p1[r] * sc2 + bias2[i1]; }
        }
        float mx = fmaxf(p0[0], p1[0]);
#pragma unroll
        for (int r = 1; r < 16; ++r) mx = fmaxf(mx, fmaxf(p0[r], p1[r]));
        mx = fmaxf(mx, __shfl_xor(mx, 32));
        const float mnew = fmaxf(mrun, mx), alpha = __builtin_amdgcn_exp2f(mrun - mnew); mrun = mnew;
        float rs = 0.f;
#pragma unroll
        for (int r = 0; r < 16; ++r) { p0[r] = __builtin_amdgcn_exp2f(p0[r] - mnew); p1[r] = __builtin_amdgcn_exp2f(p1[r] - mnew); rs += p0[r] + p1[r]; }
        lrun = lrun * alpha + rs;
        if (!__all(alpha == 1.0f)) {
        wsf[r32] = alpha;
#pragma unroll
        for (int g4 = 0; g4 < 4; ++g4) { const f32x4 a4 = *(const LAS f32x4*)(wsf + 8 * g4 + 4 * hi);
#pragma unroll
            for (int e = 0; e < 4; ++e) { o0[4 * g4 + e] *= a4[e]; o1[4 * g4 + e] *= a4[e]; } }
        }
        bf16x8 pa[4];
        { u32x4 t;
          t.x = cvt_pk_bf16(p0[0], p0[1]); t.y = cvt_pk_bf16(p0[2], p0[3]); t.z = cvt_pk_bf16(p0[4], p0[5]); t.w = cvt_pk_bf16(p0[6], p0[7]); pa[0] = __builtin_bit_cast(bf16x8, t);
          t.x = cvt_pk_bf16(p0[8], p0[9]); t.y = cvt_pk_bf16(p0[10], p0[11]); t.z = cvt_pk_bf16(p0[12], p0[13]); t.w = cvt_pk_bf16(p0[14], p0[15]); pa[1] = __builtin_bit_cast(bf16x8, t);
          t.x = cvt_pk_bf16(p1[0], p1[1]); t.y = cvt_pk_bf16(p1[2], p1[3]); t.z = cvt_pk_bf16(p1[4], p1[5]); t.w = cvt_pk_bf16(p1[6], p1[7]); pa[2] = __builtin_bit_cast(bf16x8, t);
          t.x = cvt_pk_bf16(p1[8], p1[9]); t.y = cvt_pk_bf16(p1[10], p1[11]); t.z = cvt_pk_bf16(p1[12], p1[13]); t.w = cvt_pk_bf16(p1[14], p1[15]); pa[3] = __builtin_bit_cast(bf16x8, t); }
#pragma unroll
        for (int kk = 0; kk < 4; ++kk) { const LAS unsigned char* p = wl + vbase + (16 * kk) * AV_P;
            const bf16x8 v0 = cat8(tr_read(p), tr_read(p + 8 * AV_P)), v1 = cat8(tr_read(p + 64), tr_read(p + 8 * AV_P + 64));
            o0 = __builtin_amdgcn_mfma_f32_32x32x16_bf16(pa[kk], v0, o0, 0, 0, 0);
            o1 = __builtin_amdgcn_mfma_f32_32x32x16_bf16(pa[kk], v1, o1, 0, 0, 0); }
    }
#undef ATT_LOAD
    lrun += __shfl_xor(lrun, 32);
    wsf[r32] = 1.f / lrun;
#pragma unroll
    for (int g4 = 0; g4 < 4; ++g4) { const f32x4 a4 = *(const LAS f32x4*)(wsf + 8 * g4 + 4 * hi);
#pragma unroll
        for (int e = 0; e < 4; ++e) { const int q = 8 * g4 + 4 * hi + e;
            *(LAS bf16_t*)(wl + q * 144 + r32 * 2) = (bf16_t)(cvt_pk_bf16(o0[4 * g4 + e] * a4[e], 0.f) & 0xffffu);
            *(LAS bf16_t*)(wl + q * 144 + 64 + r32 * 2) = (bf16_t)(cvt_pk_bf16(o1[4 * g4 + e] * a4[e], 0.f) & 0xffffu); } }
#pragma unroll
    for (int i = 0; i < 4; ++i) { const int row = 8 * i + (lane >> 3), chn = lane & 7; const u32x4 v = *(const LAS u32x4*)(wl + row * 144 + chn * 16);
        *(u32x4*)(MIX + (trow0 + row) * MIXP + C_QA + h * 64 + chn * 8) = v; }
}


#define XB_TMO      128
#define XB_XCNT(j)  (256  + 64 * (j))
#define XB_XSUB(j)  (1280 + 64 * (j))
#define XB_XGEN(j)  (2304 + 64 * (j))
#define XB_TOP      3328
#define XB_TOPGEN   3392
#define XCD_BAR_WORDS 3456
#define XB_SPIN_CAP (1u << 18)
__device__ __forceinline__ unsigned xb_ld(unsigned* p)              { return __hip_atomic_load(p, __ATOMIC_RELAXED, __HIP_MEMORY_SCOPE_AGENT); }
__device__ __forceinline__ unsigned xb_add(unsigned* p, unsigned v) { return __hip_atomic_fetch_add(p, v, __ATOMIC_RELAXED, __HIP_MEMORY_SCOPE_AGENT); }
__device__ __forceinline__ unsigned xb_xcc_id() { return (unsigned)__builtin_amdgcn_s_getreg((3 << 11) | 20) & 0xFu; }
#define XB_SPIN(cond, bar) do { unsigned _sp = 0; while (cond) { __builtin_amdgcn_s_sleep(1); \
    if ((++_sp & 255u) == 0u) { if (xb_ld(&(bar)[XB_TMO])) break; if (_sp > XB_SPIN_CAP) { atomicAdd(&(bar)[XB_TMO], 1u); break; } } } } while (0)
struct XcdBarrier { unsigned* bar; unsigned x; volatile LAS unsigned* st; };
__device__ __forceinline__ XcdBarrier xcd_barrier_post(unsigned* bar, volatile LAS unsigned* st) {
    XcdBarrier b; b.bar = bar; b.x = xb_xcc_id(); b.st = st;
    if (threadIdx.x == 0) (void)xb_add(&bar[XB_XCNT(b.x)], 1u);
    return b;
}
__device__ __forceinline__ void xcd_barrier_complete(unsigned* bar, unsigned x, unsigned& nloc, unsigned& nx) {
    const unsigned G = gridDim.x * gridDim.y * gridDim.z;
    unsigned sum, cnt, mine, sp = 0u;
    for (;;) {
        sum = 0u; cnt = 0u; mine = 0u;
#pragma unroll
        for (unsigned j = 0; j < 16; ++j) { const unsigned c = xb_ld(&bar[XB_XCNT(j)]); sum += c; cnt += (c > 0u) ? 1u : 0u; mine = (j == x) ? c : mine; }
        if (sum == G) break;
        __builtin_amdgcn_s_sleep(1);
        if ((++sp & 255u) == 0u) { if (xb_ld(&bar[XB_TMO])) break; if (sp > XB_SPIN_CAP) { atomicAdd(&bar[XB_TMO], 1u); break; } }
    }
    nloc = mine > 0u ? mine : 1u; nx = cnt > 0u ? cnt : 1u;
}
__device__ __forceinline__ void xcd_barrier(const XcdBarrier& b) {
    asm volatile("s_waitcnt vmcnt(0)" ::: "memory");
    __syncthreads();
    if (threadIdx.x == 0) {
        unsigned* bar = b.bar;
        __builtin_amdgcn_s_waitcnt(0);
        unsigned nloc = b.st[0], nx = b.st[1];
        if (nloc == 0u) { xcd_barrier_complete(bar, b.x, nloc, nx); b.st[0] = nloc; b.st[1] = nx; }
        const unsigned old = xb_add(&bar[XB_XSUB(b.x)], 1u);
        const unsigned gen = old / nloc;
        if (old + 1u == (gen + 1u) * nloc) {
            __builtin_amdgcn_fence(__ATOMIC_RELEASE, "agent");
            asm volatile("s_waitcnt vmcnt(0)" ::: "memory");
            const unsigned og = xb_add(&bar[XB_TOP], 1u);
            const unsigned tg = og / nx;
            if (og + 1u == (tg + 1u) * nx) xb_add(&bar[XB_TOPGEN], 1u);
            else XB_SPIN(xb_ld(&bar[XB_TOPGEN]) == tg, bar);
            __builtin_amdgcn_fence(__ATOMIC_ACQUIRE, "agent");
            xb_add(&bar[XB_XGEN(b.x)], 1u);
            asm volatile("s_waitcnt vmcnt(0)" ::: "memory");
        } else {
            XB_SPIN(xb_ld(&bar[XB_XGEN(b.x)]) == gen, bar);
            __builtin_amdgcn_fence(__ATOMIC_ACQUIRE, "agent");
            asm volatile("s_waitcnt vmcnt(0)" ::: "memory");
        }
    }
    __syncthreads();
}

__global__ void __launch_bounds__(512, 2) fwd_megakernel(Args args) {
    extern __shared__ __attribute__((aligned(16))) unsigned char lds_raw[];
    Ctx X; X.lds = (LAS unsigned char*)lds_raw; X.tid = threadIdx.x; X.lane = X.tid & 63; X.wave = __builtin_amdgcn_readfirstlane(X.tid >> 6); X.G = gridDim.x; X.bx = blockIdx.x; X.a = &args;
    unsigned char* ws = args.ws;
    float* mod = (float*)(ws + WS_MOD); float* DEC = (float*)(ws + WS_DEC);
    bf16_t* W1IN = (bf16_t*)(ws + WS_W1IN); bf16_t* W1OUT = (bf16_t*)(ws + WS_W1OUT); bf16_t* WMIX = (bf16_t*)(ws + WS_WMIX); bf16_t* WLR = (bf16_t*)(ws + WS_WLR);
    bf16_t* WPA = (bf16_t*)(ws + WS_WPA); bf16_t* WPB = (bf16_t*)(ws + WS_WPB); bf16_t* WMO = (bf16_t*)(ws + WS_WMO); bf16_t* W2IN = (bf16_t*)(ws + WS_W2IN); bf16_t* W2OUT = (bf16_t*)(ws + WS_W2OUT);
    bf16_t* U = (bf16_t*)(ws + WS_U); float* H = (float*)(ws + WS_H); bf16_t* ACT = (bf16_t*)(ws + WS_BIG); bf16_t* MIX = (bf16_t*)(ws + WS_BIG); bf16_t* UB = (bf16_t*)(ws + WS_UB); unsigned char* U8 = ws + WS_UB;     bf16_t* ST = (bf16_t*)(ws + WS_W1IN);
    float* R = args.out; bf16_t* GATES = (bf16_t*)(ws + WS_H); float* STATS = (float*)(ws + WS_STAT);
    const int lo = args.ph_lo, hi = args.ph_hi;
    cg::grid_group grid = cg::this_grid();
    volatile LAS unsigned* MISC = (volatile LAS unsigned*)(X.lds + LDS_MISC);
    if (X.tid < 16) MISC[X.tid] = 0u;
    __syncthreads();
    XcdBarrier bar; bar.bar = (unsigned*)(ws + WS_BAR); bar.x = 0; bar.st = nullptr;
    if (hi - lo > 1) { bar = xcd_barrier_post((unsigned*)(ws + WS_BAR), MISC); grid.sync(); }
#define NREP(k) (1 + ((PROBE_DUP >> (k)) & 1))
#define PHASE(k, ...) if (lo <= (k) && (k) < hi) { __VA_ARGS__ if (NREP(k) == 2) { xcd_barrier(bar); __VA_ARGS__ } }
#define SEAM(k) do { if (lo <= (k) && (k) + 1 < hi) xcd_barrier(bar); } while (0)

    PHASE(0, { p0_prologue(X); }) SEAM(0);
    PHASE(1, { p_modulate(X, args.in[I_X], mod, 0, U, U8); }) SEAM(1);
    PHASE(2, { { pg8::Gemm g{(const bf16_t*)U8, (const bf16_t*)(ws + WS_W1IN8), M_TOK, (44 - FIN_BF_TILES) * 256, DM, DM}; pg8::StaticOrder S; S.init(M_TOK, (44 - FIN_BF_TILES) * 256, X.G, X.bx); pg8::EpiSwiglu<true> E{ACT};
          pg8::gemm_phase<pg8::EpiSwiglu<true>, pg8::StaticOrder, true, true>(X.lds, g, S, E); }
        { pg8::Gemm g{U, W1IN, M_TOK, FIN_BF_TILES * 256, DM, DM}; pg8::StaticOrder S; S.init(M_TOK, FIN_BF_TILES * 256, X.G, X.bx); pg8::EpiSwiglu<false> E{ACT};
          pg8::gemm_phase<pg8::EpiSwiglu<false>, pg8::StaticOrder, true>(X.lds, g, S, E); }  }) SEAM(2);
    PHASE(3, { pg8::Gemm g{ACT, W1OUT, M_TOK, DM, DFF, DFF}; pg8::StaticOrder S; S.init(M_TOK, DM, X.G, X.bx); pg8::EpiResidT<false> E{args.in[I_X], R, mod + 2 * DM, 0.5f, nullptr, nullptr, nullptr};
        pg8::gemm_phase<pg8::EpiResidT<false>, pg8::StaticOrder, ALIGN2>(X.lds, g, S, E); }) SEAM(3);
    PHASE(4, { p_layernorm<false, true>(X, R, args.in[I_LN1G], args.in[I_LN1B], nullptr, STATS, mod, 3 * DM, U, U8); }) SEAM(4);
    PHASE(5, { { pg8::Gemm g{U, WMIX, M_TOK, 6144, DM, DM}; pg8::StaticOrder S; S.init(M_TOK, 6144, X.G, X.bx); pg8::EpiMix E{MIX, GATES};
          pg8::gemm_phase<pg8::EpiMix, pg8::StaticOrder, true>(X.lds, g, S, E); }
        { pg8::Gemm g{(const bf16_t*)U8, (const bf16_t*)(ws + WS_WG8), M_TOK, 4096, DM, DM}; pg8::StaticOrder S; S.init(M_TOK, 4096, X.G, X.bx); pg8::EpiGates8 E{GATES};
          pg8::gemm_phase<pg8::EpiGates8, pg8::StaticOrder, true, true>(X.lds, g, S, E); } }) SEAM(5);
    PHASE(6, {
        p_gla_chunk(X, U, WLR, MIX, DEC, UB, args.in[I_WA2], args.in[I_BAL]);
        LAS float* bt = (LAS float*)(X.lds + L_ABIAS);
        for (int i = X.tid; i < 16 * 320; i += 512) bt[i] = args.in[I_RELB][i] * LOG2E;
        __syncthreads();
        for (int uid = X.bx * 8 + X.wave; uid < 8192; uid += X.G * 8) { const int half = uid & 1, n = (uid >> 1) & 63, bh = uid >> 7; attn_unit(X, MIX, bh >> 4, bh & 15, n, half); }
    }) SEAM(6);
    PHASE(7, { p_gla_scan_elem(X, DEC, UB, ST); }) SEAM(7);
    PHASE(8, { p_gla_readout(X, MIX, ST, args.in[I_GNG]); }) SEAM(8);
    PHASE(9, { pg8::Gemm g{MIX + C_QA, WPA, M_TOK, DM, 1024, MIXP}; pg8::StaticOrder S; S.init(M_TOK, DM, X.G, X.bx); pg8::EpiGate<false> E{GATES, U, nullptr};
        pg8::gemm_phase<pg8::EpiGate<false>, pg8::StaticOrder, true>(X.lds, g, S, E); asm volatile("s_waitcnt vmcnt(0)" ::: "memory"); __syncthreads(); })
    PHASE(10, { pg8::Gemm g{MIX + C_RB, WPB, M_TOK, DM, 1024, MIXP}; pg8::StaticOrder S; S.init(M_TOK, DM, X.G, X.bx); pg8::EpiGate<true> E{GATES + 2048, U, MIX + C_MERGED};
        pg8::gemm_phase<pg8::EpiGate<true>, pg8::StaticOrder, true>(X.lds, g, S, E); }) SEAM(10);
    PHASE(11, { pg8::Gemm g{MIX + C_MERGED, WMO, M_TOK, DM, DM, MIXP}; pg8::StaticOrder S; S.init(M_TOK, DM, X.G, X.bx); pg8::EpiResidT<true> E{R, R, mod + 5 * DM, 1.0f, STATS, args.in[I_LN1G], args.in[I_LN1B]};
        pg8::gemm_phase<pg8::EpiResidT<true>, pg8::StaticOrder, ALIGN2>(X.lds, g, S, E); }) SEAM(11);
    PHASE(12, { p_layernorm<false, true>(X, R, args.in[I_LN2G], args.in[I_LN2B], nullptr, STATS, mod, 6 * DM, U, U8); }) SEAM(12);
    PHASE(13, { { pg8::Gemm g{(const bf16_t*)U8, (const bf16_t*)(ws + WS_W2IN8), M_TOK, (44 - FIN_BF_TILES) * 256, DM, DM}; pg8::StaticOrder S; S.init(M_TOK, (44 - FIN_BF_TILES) * 256, X.G, X.bx); pg8::EpiSwiglu<true> E{ACT};
          pg8::gemm_phase<pg8::EpiSwiglu<true>, pg8::StaticOrder, true, true>(X.lds, g, S, E); }
        { pg8::Gemm g{U, W2IN, M_TOK, FIN_BF_TILES * 256, DM, DM}; pg8::StaticOrder S; S.init(M_TOK, FIN_BF_TILES * 256, X.G, X.bx); pg8::EpiSwiglu<false> E{ACT};
          pg8::gemm_phase<pg8::EpiSwiglu<false>, pg8::StaticOrder, true>(X.lds, g, S, E); }  }) SEAM(13);
    PHASE(14, { pg8::Gemm g{ACT, W2OUT, M_TOK, DM, DFF, DFF}; pg8::StaticOrder S; S.init(M_TOK, DM, X.G, X.bx); pg8::EpiResidT<true> E{R, R, mod + 8 * DM, 0.5f, STATS, args.in[I_LN2G], args.in[I_LN2B]};
        pg8::gemm_phase<pg8::EpiResidT<true>, pg8::StaticOrder, ALIGN2>(X.lds, g, S, E); }) SEAM(14);
    PHASE(15, { p_layernorm<true>(X, R, args.in[I_LN3G], args.in[I_LN3B], R, nullptr, nullptr, 0, nullptr); })
#undef PHASE
#undef SEAM
}

constexpr int N_PHASES = 16;

extern "C" void kernel_launch(void* const* d_in, const int* in_sizes, int n_in, void* d_out, int out_size, void* d_ws, size_t ws_size, hipStream_t stream) {
    static int grid = 0;
    if (grid == 0) {
        if (n_in != 22 || out_size != M_TOK * DM || ws_size < WS_END) { fprintf(stderr, "kernel_launch: unexpected shapes (n_in %d, out %d, ws %zu < %zu)\n", n_in, out_size, ws_size, (size_t)WS_END); grid = -1; return; }
        int dev = 0, cus = 0, per_cu = 0;
        (void)hipGetDevice(&dev); (void)hipDeviceGetAttribute(&cus, hipDeviceAttributeMultiprocessorCount, dev);
        if (hipFuncSetAttribute((const void*)fwd_megakernel, hipFuncAttributeMaxDynamicSharedMemorySize, LDS_BYTES) != hipSuccess) { fprintf(stderr, "kernel_launch: hipFuncSetAttribute failed\n"); grid = -1; return; }
        if (hipOccupancyMaxActiveBlocksPerMultiprocessor(&per_cu, (const void*)fwd_megakernel, 512, LDS_BYTES) != hipSuccess || per_cu < 1) { fprintf(stderr, "kernel_launch: occupancy query says %d\n", per_cu); per_cu = 1; }
        (void)hipGetLastError();
        grid = cus > 0 ? cus : 256;
    }
    if (grid < 0) return;
    if (hipMemsetAsync((char*)d_ws + WS_BAR, 0, BAR_BYTES, stream) != hipSuccess) { fprintf(stderr, "kernel_launch: memset of the barrier words failed\n"); return; }
    Args a{};
    for (int i = 0; i < 22; ++i) a.in[i] = (const float*)d_in[i];
    a.out = (float*)d_out; a.ws = (unsigned char*)d_ws;
#if MK_COOP
    a.ph_lo = 0; a.ph_hi = N_PHASES;
    void* kargs[] = {&a};
    hipError_t e = hipLaunchCooperativeKernel((const void*)fwd_megakernel, dim3(grid), dim3(512), kargs, LDS_BYTES, stream);
    if (e != hipSuccess) fprintf(stderr, "kernel_launch: cooperative launch failed: %s (grid %d)\n", hipGetErrorString(e), grid);
#else
    for (int ph = 0; ph < N_PHASES; ++ph) { a.ph_lo = ph; a.ph_hi = ph + 1; hipLaunchKernelGGL(fwd_megakernel, dim3(grid), dim3(512), LDS_BYTES, stream, a); }
#endif
}
```

```cpp
#include <hip/hip_runtime.h>
#include <hip/hip_cooperative_groups.h>
#include <cstdio>
#include <cstdint>
namespace cg = cooperative_groups;

#ifndef MK_COOP
#define MK_COOP 1
#endif

#ifndef ALIGN2
#define ALIGN2 false
#endif
#ifndef PROBE_DUP
#define PROBE_DUP 0
#endif

#define LAS __attribute__((address_space(3)))
typedef unsigned short bf16_t;
typedef short bf16x8 __attribute__((ext_vector_type(8)));
typedef float f32x4 __attribute__((ext_vector_type(4)));
typedef float f32x16 __attribute__((ext_vector_type(16)));
typedef unsigned u32x4 __attribute__((ext_vector_type(4)));
typedef unsigned u32x2 __attribute__((ext_vector_type(2)));
typedef short s16x4 __attribute__((ext_vector_type(4)));
typedef int i32x4 __attribute__((ext_vector_type(4)));
typedef int i32x8 __attribute__((ext_vector_type(8)));
constexpr int FIN_BF_TILES = 36;
constexpr float G8_SCALE = 64.f;

constexpr int M_TOK = 16384, DM = 2048, DFF = 5632, SEQ = 4096, NMOD = 18432;
constexpr int MIXP = 6144;
constexpr int GP = 4096;
constexpr int C_QA = 0, C_KA = 1024, C_VA = 2048, C_QB = 3072, C_KB = 3584, C_VB = 4096, C_RB = 5120, C_MERGED = 1024;
constexpr int WMIX_SRC_LD = 10256;
constexpr float ALPHA = 1.189207115002721f;
constexpr float LN_EPS = 1e-5f, RMS_EPS = 1e-6f;
constexpr float LOG2E = 1.4426950408889634f;

constexpr size_t MiB = 1u << 20;
constexpr size_t WS_BAR = 320 * 1024, BAR_BYTES = 16384;
constexpr size_t WS_STAT = 336 * 1024;
constexpr size_t WS_MOD = 4096;
constexpr size_t WS_DEC = 512 * 1024;
constexpr size_t WS_W1IN = 1 * MiB, WS_W1OUT = 45 * MiB, WS_WMIX = 67 * MiB, WS_WLR = 107 * MiB, WS_WPA = 108 * MiB, WS_WPB = 112 * MiB,
                 WS_WMO = 116 * MiB, WS_W2IN = 124 * MiB, WS_W2OUT = 168 * MiB, WS_U = 190 * MiB, WS_H = 254 * MiB, WS_BIG = 382 * MiB, WS_UB = 574 * MiB, WS_W1IN8 = 638 * MiB, WS_W2IN8 = 642 * MiB, WS_END = 646 * MiB;

constexpr size_t WS_WG8 = 91 * MiB;
constexpr int LDS_MISC = 147456 - 64;
constexpr int LDS_BYTES = 147456;

typedef float f32x2_t __attribute__((ext_vector_type(2))); typedef __bf16 bf16x2_t __attribute__((ext_vector_type(2)));
__device__ __forceinline__ unsigned cvt_pk_bf16(float lo, float hi) { const f32x2_t v = {lo, hi}; const bf16x2_t b = __builtin_convertvector(v, bf16x2_t); return __builtin_bit_cast(unsigned, b); }
__device__ __forceinline__ float bf_lo(unsigned w) { return __uint_as_float(w << 16); }
__device__ __forceinline__ float bf_hi(unsigned w) { return __uint_as_float(w & 0xffff0000u); }
__device__ __forceinline__ float fast_sigmoid(float x) { return __builtin_amdgcn_rcpf(1.f + __builtin_amdgcn_exp2f(-LOG2E * x)); }
__device__ __forceinline__ float fast_silu(float x) { return x * fast_sigmoid(x); }
__device__ __forceinline__ f32x2_t sigmoid_pk(f32x2_t x) { const f32x2_t t = x * (-LOG2E); f32x2_t e; e[0] = __builtin_amdgcn_exp2f(t[0]); e[1] = __builtin_amdgcn_exp2f(t[1]);
    const f32x2_t d = e + 1.0f; f32x2_t r; r[0] = __builtin_amdgcn_rcpf(d[0]); r[1] = __builtin_amdgcn_rcpf(d[1]); return r; }
template <bool F8> __device__ __forceinline__ f32x2_t sigmoid_sc_pk(f32x2_t x) { constexpr float k = F8 ? -LOG2E / 64.f : -LOG2E; const f32x2_t t = x * k; f32x2_t e; e[0] = __builtin_amdgcn_exp2f(t[0]); e[1] = __builtin_amdgcn_exp2f(t[1]);
    const f32x2_t d = e + 1.0f; f32x2_t r; r[0] = __builtin_amdgcn_rcpf(d[0]); r[1] = __builtin_amdgcn_rcpf(d[1]); return r; }
template <bool F8> __device__ __forceinline__ f32x4 swiglu_pk4(f32x4 a, f32x4 b) { const f32x2_t a0 = {a[0], a[1]}, a1 = {a[2], a[3]}, b0 = {b[0], b[1]}, b1 = {b[2], b[3]};
    constexpr float s2 = F8 ? 1.f / (64.f * 64.f) : 1.f;
    f32x2_t o0 = (a0 * b0) * sigmoid_sc_pk<F8>(a0), o1 = (a1 * b1) * sigmoid_sc_pk<F8>(a1); if constexpr (F8) { o0 = o0 * s2; o1 = o1 * s2; } return (f32x4){o0[0], o0[1], o1[0], o1[1]}; }
__device__ __forceinline__ f32x4 gate_pk4(f32x4 v, unsigned glo, unsigned ghi) {
    const f32x2_t g0 = {__uint_as_float(glo << 16), __uint_as_float(glo & 0xffff0000u)}, g1 = {__uint_as_float(ghi << 16), __uint_as_float(ghi & 0xffff0000u)};
    const f32x2_t v0 = {v[0], v[1]}, v1 = {v[2], v[3]}; const f32x2_t o0 = v0 * sigmoid_pk(g0), o1 = v1 * sigmoid_pk(g1); return (f32x4){o0[0], o0[1], o1[0], o1[1]}; }
__device__ __forceinline__ float wave_sum(float v) {
#pragma unroll
    for (int o = 1; o < 64; o <<= 1) v += __shfl_xor(v, o);
    return v;
}

namespace pg8 {
constexpr int BM = 256, BK = 64, HALF = 128, HTB = HALF * BK * 2, STAGE_BYTES = 8 * HTB, NXCD = 8, WGM = 8;
__host__ __device__ __forceinline__ int lds_byte(int r, int c) { const int st = (r >> 4) * 2 + (c >> 5), rr = r & 15, cc = c & 31, ob = rr * 64 + cc * 2; return st * 1024 + (ob ^ (((ob >> 9) & 1) << 5)); }
__host__ __device__ __forceinline__ void stage_rc(int b, int& R, int& C) { const int st = b / 1024, sb = b % 1024, swz = sb ^ (((sb >> 9) & 1) << 5); R = (st >> 1) * 16 + swz / 64; C = (st & 1) * 32 + (swz % 64) / 2; }
__host__ __device__ __forceinline__ int perm32(int rho) { const int n = rho >> 4, i = rho & 15; return 8 * (i >> 2) + 4 * n + (i & 3); }

struct Unit { int pm, pn; };
struct Gemm { const bf16_t* A; const bf16_t* Bt; int M, N, K, lda; };

struct StaticOrder {
    int nM, nN, nwg, G, c;
    __host__ __device__ void init(int M, int N, int G_, int c_) { nM = M / BM; nN = N / BM; nwg = nM * nN; G = G_; c = c_; }
    __host__ __device__ bool next(int i, Unit& u) const {
        const long L = (long)i * G + c; if (L >= nwg) return false;
        int wgid = (int)L; { const int q = nwg / NXCD, r = nwg % NXCD, xcd = wgid % NXCD, off = wgid / NXCD; wgid = (xcd < r ? xcd * (q + 1) : r * (q + 1) + (xcd - r) * q) + off; }
        const int nig = WGM * nN, gid = wgid / nig, fm = gid * WGM, gsz = (nM - fm) < WGM ? (nM - fm) : WGM;
        u.pm = fm + ((wgid % nig) % gsz); u.pn = (wgid % nig) / gsz; return true;
    }
};

template <class Epi, class Sched, bool ALIGN_EPI, bool FP8 = false>
__device__ __forceinline__ void gemm_phase(LAS unsigned char* lds, const Gemm g, const Sched& S, const Epi& E) {
    int tid_ = threadIdx.x; asm volatile("" : "+v"(tid_));
    const int tid = tid_, wid = __builtin_amdgcn_readfirstlane(tid >> 6), lane = tid & 63, wr = wid >> 2, wc = wid & 3, fr = lane & 15, fq = lane >> 4;
    const int K = g.K, nt = FP8 ? K / 128 : K / BK, lda = g.lda;
    const int pitchA = FP8 ? lda : lda * 2, pitchB = FP8 ? K : K * 2;
    unsigned voffA[2], voffB[2];
#pragma unroll
    for (int i = 0; i < 2; ++i) { int R, C; stage_rc(tid * 16 + i * 8192, R, C); const int Rb = Epi::PERM ? ((R & ~31) + perm32(R & 31)) : R;
        voffA[i] = (unsigned)(R * pitchA + C * 2); voffB[i] = (unsigned)(Rb * pitchB + C * 2); }
    const size_t kstep = (size_t)(BK * 2);
    const size_t hstepA = (size_t)HALF * pitchA, hstepB = (size_t)HALF * pitchB;
    const size_t tstepA = 2 * hstepA, tstepB = 2 * hstepB;
    const unsigned ldsw = (unsigned)wid * 1024u;
    const int aoff = lds_byte(wr * 64 + fr, fq * 8), boff = lds_byte(wc * 32 + fr, fq * 8);
#define PG8_SA(b, h) (((b) * 2 + (h)) * HTB)
#define PG8_SB(b, h) ((4 + (b) * 2 + (h)) * HTB)
#define PG8_STAGE(bufoff, gbase, voff) do { _Pragma("unroll") for (int _i = 0; _i < 2; ++_i) \
        __builtin_amdgcn_global_load_lds((const unsigned*)((const char*)(gbase) + (voff)[_i]), (LAS unsigned*)(lds + (bufoff) + ldsw + _i * 8192), 16, 0, 0); } while (0)
#define PG8_LD8(off) __builtin_shufflevector(*(const LAS i32x4*)(lds + (off)), *(const LAS i32x4*)(lds + (off) + 1024), 0, 1, 2, 3, 4, 5, 6, 7)
#define PG8_LDA(dst, b, h) do { if constexpr (FP8) { _Pragma("unroll") for (int m = 0; m < 4; ++m) dst##8[m] = PG8_LD8(PG8_SA(b, h) + aoff + m * 2048); } \
        else { _Pragma("unroll") for (int m = 0; m < 4; ++m) _Pragma("unroll") for (int k = 0; k < 2; ++k) dst[m][k] = *(const LAS bf16x8*)(lds + PG8_SA(b, h) + aoff + m * 2048 + k * 1024); } } while (0)
#define PG8_LDB(dst, b, h) do { if constexpr (FP8) { _Pragma("unroll") for (int n = 0; n < 2; ++n) dst##8[n] = PG8_LD8(PG8_SB(b, h) + boff + n * 2048); } \
        else { _Pragma("unroll") for (int n = 0; n < 2; ++n) _Pragma("unroll") for (int k = 0; k < 2; ++k) dst[n][k] = *(const LAS bf16x8*)(lds + PG8_SB(b, h) + boff + n * 2048 + k * 1024); } } while (0)
#define PG8_CAT8(x) __builtin_shufflevector(__builtin_bit_cast(i32x4, (x)[0]), __builtin_bit_cast(i32x4, (x)[1]), 0, 1, 2, 3, 4, 5, 6, 7)
#define PG8_MMA(ai, bj, At, Bt) do { __builtin_amdgcn_s_setprio(1); \
        if constexpr (FP8) { _Pragma("unroll") for (int m = 0; m < 4; ++m) _Pragma("unroll") for (int n = 0; n < 2; ++n) \
            asm volatile("v_mfma_f32_16x16x128_f8f6f4 %0, %1, %2, %0" : "+v"(acc[ai][bj][m][n]) : "v"(Bt##8[n]), "v"(At##8[m])); } \
        else { _Pragma("unroll") for (int m = 0; m < 4; ++m) _Pragma("unroll") for (int n = 0; n < 2; ++n) _Pragma("unroll") for (int k = 0; k < 2; ++k) \
            acc[ai][bj][m][n] = __builtin_amdgcn_mfma_f32_16x16x32_bf16(Bt[n][k], At[m][k], acc[ai][bj][m][n], 0, 0, 0); } \
        __builtin_amdgcn_s_setprio(0); } while (0)
#define PG8_WAIT_V(n) asm volatile("s_waitcnt vmcnt(" #n ")" ::: "memory")
#define PG8_WAIT_L(n) asm volatile("s_waitcnt lgkmcnt(" #n ")" ::: "memory")
#define PG8_BAR __builtin_amdgcn_s_barrier()
#define PG8_SCHED __builtin_amdgcn_sched_barrier(0)
    Unit cur, nxt; int ui = 0;
    if (!S.next(0, cur)) return;
    f32x4 acc[2][2][4][2];
#pragma unroll
    for (int a = 0; a < 2; ++a)
#pragma unroll
        for (int b = 0; b < 2; ++b)
#pragma unroll
            for (int m = 0; m < 4; ++m)
#pragma unroll
                for (int n = 0; n < 2; ++n) acc[a][b][m][n] = (f32x4){0.f, 0.f, 0.f, 0.f};
    bf16x8 At[4][2], B0[2][2], B1[2][2];
    i32x8 At8[4], B08[2], B18[2];
    const char* cA = (const char*)g.A + (size_t)cur.pm * tstepA; const char* cB = (const char*)g.Bt + (size_t)cur.pn * tstepB;
    PG8_STAGE(PG8_SB(0, 0), cB, voffB); PG8_STAGE(PG8_SB(0, 1), cB + hstepB, voffB); PG8_STAGE(PG8_SA(0, 0), cA, voffA); PG8_STAGE(PG8_SA(0, 1), cA + hstepA, voffA);
    if (wr == 1) PG8_BAR;
    PG8_WAIT_V(2); PG8_BAR;
    PG8_STAGE(PG8_SB(1, 0), cB + kstep, voffB); PG8_STAGE(PG8_SA(1, 0), cA + kstep, voffA); PG8_STAGE(PG8_SB(1, 1), cB + hstepB + kstep, voffB);
    PG8_WAIT_V(6); PG8_BAR;
    for (;;) {
        const bool has_next = S.next(ui + 1, nxt);
        const char* nA = has_next ? (const char*)g.A + (size_t)nxt.pm * tstepA : cA; const char* nB = has_next ? (const char*)g.Bt + (size_t)nxt.pn * tstepB : cB;
        for (int t = 0; t < nt; t += 2) {
            const bool last = (t == nt - 2);
            const char* a1 = cA + (size_t)(t + 1) * kstep;
            const char* a2 = last ? nA : cA + (size_t)(t + 2) * kstep; const char* b2 = last ? nB : cB + (size_t)(t + 2) * kstep;
            const char* a3 = a2 + kstep; const char* b3 = b2 + kstep;
            PG8_LDB(B0, 0, 0); PG8_LDB(B1, 0, 1); PG8_SCHED; PG8_LDA(At, 0, 0); PG8_STAGE(PG8_SA(1, 1), a1 + hstepA, voffA);
            PG8_WAIT_V(8); PG8_WAIT_L(0); PG8_BAR; PG8_MMA(0, 0, At, B0); PG8_MMA(0, 1, At, B1); PG8_BAR; PG8_SCHED;
            PG8_LDA(At, 0, 1); PG8_STAGE(PG8_SB(0, 0), b2, voffB); PG8_STAGE(PG8_SB(0, 1), b2 + hstepB, voffB); PG8_STAGE(PG8_SA(0, 0), a2, voffA);
            PG8_WAIT_V(8); PG8_WAIT_L(0); PG8_BAR; PG8_MMA(1, 0, At, B0); PG8_MMA(1, 1, At, B1); PG8_BAR; PG8_SCHED;
            PG8_LDB(B0, 1, 0); PG8_LDB(B1, 1, 1); PG8_SCHED; PG8_LDA(At, 1, 0); PG8_STAGE(PG8_SA(0, 1), a2 + hstepA, voffA);
            PG8_WAIT_V(8); PG8_WAIT_L(0); PG8_BAR; PG8_MMA(0, 0, At, B0); PG8_MMA(0, 1, At, B1); PG8_BAR; PG8_SCHED;
            PG8_LDA(At, 1, 1); PG8_STAGE(PG8_SB(1, 0), b3, voffB); PG8_STAGE(PG8_SB(1, 1), b3 + hstepB, voffB); PG8_STAGE(PG8_SA(1, 0), a3, voffA);
            PG8_WAIT_V(8); PG8_WAIT_L(0); PG8_BAR; PG8_MMA(1, 0, At, B0); PG8_MMA(1, 1, At, B1); PG8_BAR; PG8_SCHED;
        }
        if constexpr (ALIGN_EPI) { if (wr == 0) PG8_BAR; }
        E(acc, cur, wr, wc, fr, fq);
        if (!has_next) break;
#pragma unroll
        for (int a = 0; a < 2; ++a)
#pragma unroll
            for (int b = 0; b < 2; ++b)
#pragma unroll
                for (int m = 0; m < 4; ++m)
#pragma unroll
                    for (int n = 0; n < 2; ++n) acc[a][b][m][n] = (f32x4){0.f, 0.f, 0.f, 0.f};
        cur = nxt; cA = nA; cB = nB; ++ui;
        if constexpr (ALIGN_EPI) { if (wr == 1) PG8_BAR; }
    }
    PG8_WAIT_V(0);
    if constexpr (!ALIGN_EPI) { if (wr == 0) PG8_BAR; }
    PG8_BAR;
#undef PG8_SA
#undef PG8_SB
#undef PG8_STAGE
#undef PG8_LDA
#undef PG8_LD8
#undef PG8_LDB
#undef PG8_MMA
#undef PG8_CAT8
#undef PG8_WAIT_V
#undef PG8_WAIT_L
#undef PG8_BAR
#undef PG8_SCHED
}

typedef const f32x4 (&AccRef)[2][2][4][2];
__device__ __forceinline__ u32x4 pack8(f32x4 v0, f32x4 v1) { u32x4 w; w.x = cvt_pk_bf16(v0[0], v0[1]); w.y = cvt_pk_bf16(v0[2], v0[3]); w.z = cvt_pk_bf16(v1[0], v1[1]); w.w = cvt_pk_bf16(v1[2], v1[3]); return w; }

template <bool F8> struct EpiSwiglu {
    static constexpr bool PERM = true;
    bf16_t* O;
    __device__ __forceinline__ void operator()(AccRef acc, const Unit& u, int wr, int wc, int fr, int fq) const {
        constexpr int col_base = F8 ? FIN_BF_TILES * 128 : 0; constexpr float sc = F8 ? 1.f / G8_SCALE : 1.f;
        const int row0 = u.pm * BM + wr * 64 + fr, col0 = col_base + u.pn * HALF + wc * 32 + 8 * fq;
#pragma unroll
        for (int ai = 0; ai < 2; ++ai)
#pragma unroll
            for (int m = 0; m < 4; ++m) {
                bf16_t* p = O + (size_t)(row0 + ai * HALF + m * 16) * DFF + col0;
                const f32x4 v0 = swiglu_pk4<F8>(acc[ai][0][m][0], acc[ai][1][m][0]), v1 = swiglu_pk4<F8>(acc[ai][0][m][1], acc[ai][1][m][1]);
                *(u32x4*)p = pack8(v0, v1);
                if constexpr (F8) asm volatile("" ::: "memory");
            }
    }
};
template <bool LN> struct EpiResidT {
    static constexpr bool PERM = false;
    const float* hin; float* R; const float* gate; float gs; const float* stats; const float* lng; const float* lnb;
    __device__ __forceinline__ void operator()(AccRef acc, const Unit& u, int wr, int wc, int fr, int fq) const {
        const int row0 = u.pm * BM + wr * 64 + fr, col0 = u.pn * BM + wc * 32 + 4 * fq;
        const float* gp = gate + (size_t)(u.pm >> 4) * NMOD + col0;
        f32x2_t st[2][4];
#pragma unroll
        for (int ai = 0; ai < 2; ++ai)
#pragma unroll
            for (int m = 0; m < 4; ++m) { if constexpr (LN) st[ai][m] = *(const f32x2_t*)(stats + 2 * (size_t)(row0 + ai * HALF + m * 16)); else st[ai][m] = (f32x2_t){0.f, 1.f}; }
#pragma unroll
        for (int bj = 0; bj < 2; ++bj)
#pragma unroll
            for (int n = 0; n < 2; ++n) {
                const int co = bj * HALF + 16 * n;
                const f32x4 gv = *(const f32x4*)(gp + co) * gs;
                f32x4 lg4 = (f32x4){1.f, 1.f, 1.f, 1.f}, lb4 = (f32x4){0.f, 0.f, 0.f, 0.f};
                if constexpr (LN) { lg4 = *(const f32x4*)(lng + col0 + co); lb4 = *(const f32x4*)(lnb + col0 + co); }
                f32x4 hv[2][4];
#pragma unroll
                for (int ai = 0; ai < 2; ++ai)
#pragma unroll
                    for (int m = 0; m < 4; ++m) hv[ai][m] = *(const f32x4*)(hin + (size_t)(row0 + ai * HALF + m * 16) * DM + col0 + co);
#pragma unroll
                for (int ai = 0; ai < 2; ++ai)
#pragma unroll
                    for (int m = 0; m < 4; ++m) { const size_t off = (size_t)(row0 + ai * HALF + m * 16) * DM + col0 + co;
                        f32x4 h = hv[ai][m];
                        if constexpr (LN) h = (h - st[ai][m][0]) * st[ai][m][1] * lg4 + lb4;
                        *(f32x4*)(R + off) = h * ALPHA + gv * acc[ai][bj][m][n]; }
            }
    }
};
struct EpiMix {
    static constexpr bool PERM = true;
    bf16_t* MIX; bf16_t* GATES;
    __device__ __forceinline__ void operator()(AccRef acc, const Unit& u, int wr, int wc, int fr, int fq) const {
        const int row0 = u.pm * BM + wr * 64 + fr; int colt = u.pn * BM; bf16_t* base = MIX; int ldc = MIXP;
        if (colt >= 6144) { base = GATES; ldc = GP; colt -= 6144; }
        const int col0 = colt + wc * 32 + 8 * fq;
#pragma unroll
        for (int ai = 0; ai < 2; ++ai)
#pragma unroll
            for (int m = 0; m < 4; ++m) { bf16_t* p = base + (size_t)(row0 + ai * HALF + m * 16) * ldc + col0;
#pragma unroll
                for (int bj = 0; bj < 2; ++bj) *(u32x4*)(p + bj * HALF) = pack8(acc[ai][bj][m][0], acc[ai][bj][m][1]); }
    }
};
struct EpiGates8 {
    static constexpr bool PERM = true;
    bf16_t* GATES;
    __device__ __forceinline__ void operator()(AccRef acc, const Unit& u, int wr, int wc, int fr, int fq) const {
        const int row0 = u.pm * BM + wr * 64 + fr, col0 = u.pn * BM + wc * 32 + 8 * fq; const float sc = 1.f / G8_SCALE;
#pragma unroll
        for (int ai = 0; ai < 2; ++ai)
#pragma unroll
            for (int m = 0; m < 4; ++m) { bf16_t* p = GATES + (size_t)(row0 + ai * HALF + m * 16) * GP + col0;
#pragma unroll
                for (int bj = 0; bj < 2; ++bj) *(u32x4*)(p + bj * HALF) = pack8(acc[ai][bj][m][0] * sc, acc[ai][bj][m][1] * sc); }
    }
};
template <bool SECOND> struct EpiGate {
    static constexpr bool PERM = true;
    const bf16_t* G;
    bf16_t* T;
    bf16_t* OUT;
    __device__ __forceinline__ void operator()(AccRef acc, const Unit& u, int wr, int wc, int fr, int fq) const {
        const int row0 = u.pm * BM + wr * 64 + fr, col0 = u.pn * BM + wc * 32 + 8 * fq;
#pragma unroll
        for (int ai = 0; ai < 2; ++ai)
#pragma unroll
            for (int bj = 0; bj < 2; ++bj) {
                u32x4 gw[4], tw[4];
#pragma unroll
                for (int m = 0; m < 4; ++m) { const size_t row = (size_t)(row0 + ai * HALF + m * 16);
                    gw[m] = *(const u32x4*)(G + row * GP + col0 + bj * HALF);
                    if constexpr (SECOND) tw[m] = *(const u32x4*)(T + row * DM + col0 + bj * HALF); }
#pragma unroll
                for (int m = 0; m < 4; ++m) { const size_t row = (size_t)(row0 + ai * HALF + m * 16);
                    f32x4 v0 = gate_pk4(acc[ai][bj][m][0], gw[m].x, gw[m].y), v1 = gate_pk4(acc[ai][bj][m][1], gw[m].z, gw[m].w);
                    if constexpr (SECOND) {
                        v0[0] += bf_lo(tw[m].x); v0[1] += bf_hi(tw[m].x); v0[2] += bf_lo(tw[m].y); v0[3] += bf_hi(tw[m].y);
                        v1[0] += bf_lo(tw[m].z); v1[1] += bf_hi(tw[m].z); v1[2] += bf_lo(tw[m].w); v1[3] += bf_hi(tw[m].w);
                        *(u32x4*)(OUT + row * MIXP + col0 + bj * HALF) = pack8(v0, v1);
                    } else {
                        *(u32x4*)(T + row * DM + col0 + bj * HALF) = pack8(v0, v1);
                    }
                }
            }
    }
};
}

struct Args { const float* in[22]; float* out; unsigned char* ws; int ph_lo, ph_hi; };
enum { I_X = 0, I_C, I_WADA, I_BADA, I_F1IN, I_F1OUT, I_LN1G, I_LN1B, I_WMIX, I_RELB, I_WA2, I_BAL, I_GNG, I_WPA, I_WPB, I_WMO, I_LN2G, I_LN2B, I_F2IN, I_F2OUT, I_LN3G, I_LN3B };

struct Ctx {
    LAS unsigned char* lds; int tid, lane, wave, G, bx;
    const Args* a;
};

__device__ __forceinline__ void tr_item(const float* W, int ldw, int K, int k0, int c0, bf16_t* WT, int r0, int ncols, LAS float* scr, int lane) {
    const int cl = lane & 31;
    float tv[32];
#pragma unroll
    for (int i = 0; i < 32; ++i) { const int kk = 2 * i + (lane >> 5); tv[i] = (cl < ncols) ? W[(size_t)(k0 + kk) * ldw + c0 + cl] : 0.f; }
#pragma unroll
    for (int i = 0; i < 32; ++i) { const int kk = 2 * i + (lane >> 5); scr[kk * 33 + cl] = tv[i]; }
    asm volatile("s_waitcnt lgkmcnt(0)" ::: "memory");
    const int c = lane & 7;
#pragma unroll
    for (int j = 0; j < 4; ++j) { const int n = (lane >> 3) + 8 * j; const LAS float* s = scr + (8 * c) * 33 + n;
        u32x4 o; o.x = cvt_pk_bf16(s[0 * 33], s[1 * 33]); o.y = cvt_pk_bf16(s[2 * 33], s[3 * 33]); o.z = cvt_pk_bf16(s[4 * 33], s[5 * 33]); o.w = cvt_pk_bf16(s[6 * 33], s[7 * 33]);
        if (n < ncols) *(u32x4*)(WT + (size_t)(r0 + n) * K + k0 + 8 * c) = o; }
    asm volatile("s_waitcnt lgkmcnt(0)" ::: "memory");
}

__device__ __forceinline__ unsigned pk4_fp8(float a, float b, float c, float d) { int w = 0; w = __builtin_amdgcn_cvt_pk_fp8_f32(a, b, w, false); w = __builtin_amdgcn_cvt_pk_fp8_f32(c, d, w, true); return (unsigned)w; }
__device__ __forceinline__ void tr_item8(const float* W, int ldw, int K, int k0, int c0, unsigned char* W8, int r0, LAS float* scr, int lane) {
    const int cl = lane & 31;
    float tv[32];
#pragma unroll
    for (int i = 0; i < 32; ++i) { const int kk = 2 * i + (lane >> 5); tv[i] = W[(size_t)(k0 + kk) * ldw + c0 + cl] * G8_SCALE; }
#pragma unroll
    for (int i = 0; i < 32; ++i) { const int kk = 2 * i + (lane >> 5); scr[kk * 33 + cl] = tv[i]; }
    asm volatile("s_waitcnt lgkmcnt(0)" ::: "memory");
    const int c = lane & 3;
#pragma unroll
    for (int j = 0; j < 2; ++j) { const int n = (lane >> 2) + 16 * j; const LAS float* s = scr + (16 * c) * 33 + n;
        u32x4 o; o.x = pk4_fp8(s[0 * 33], s[1 * 33], s[2 * 33], s[3 * 33]); o.y = pk4_fp8(s[4 * 33], s[5 * 33], s[6 * 33], s[7 * 33]);
        o.z = pk4_fp8(s[8 * 33], s[9 * 33], s[10 * 33], s[11 * 33]); o.w = pk4_fp8(s[12 * 33], s[13 * 33], s[14 * 33], s[15 * 33]);
        *(u32x4*)(W8 + (size_t)(r0 + n) * K + k0 + 16 * c) = o; }
    asm volatile("s_waitcnt lgkmcnt(0)" ::: "memory");
}

__device__ __forceinline__ void p0_prologue(const Ctx& X) {
    const Args& a = *X.a; unsigned char* ws = a.ws;
    LAS float* sl = (LAS float*)X.lds;
    LAS float* red = (LAS float*)(X.lds + 32768);
    for (int i = X.tid; i < 4 * DM; i += 512) sl[i] = fast_silu(a.in[I_C][i]);
    __syncthreads();
    float* mod = (float*)(ws + WS_MOD);
    for (int it = X.bx; it < NMOD / 64; it += X.G) {
        const int j0 = it * 64; const float* wp = a.in[I_WADA] + (size_t)(256 * X.wave) * NMOD + j0 + X.lane;
        float a0 = 0.f, a1 = 0.f, a2 = 0.f, a3 = 0.f;
        for (int k8 = 0; k8 < 256; k8 += 32) { float wv[32];
#pragma unroll
            for (int q = 0; q < 32; ++q) wv[q] = wp[(size_t)(k8 + q) * NMOD];
#pragma unroll
            for (int q = 0; q < 32; ++q) { const int k = 256 * X.wave + k8 + q; a0 += sl[k] * wv[q]; a1 += sl[DM + k] * wv[q]; a2 += sl[2 * DM + k] * wv[q]; a3 += sl[3 * DM + k] * wv[q]; } }
        red[(X.wave * 4 + 0) * 64 + X.lane] = a0; red[(X.wave * 4 + 1) * 64 + X.lane] = a1; red[(X.wave * 4 + 2) * 64 + X.lane] = a2; red[(X.wave * 4 + 3) * 64 + X.lane] = a3;
        __syncthreads();
        if (X.tid < 256) { const int b = X.tid >> 6, l = X.tid & 63; float s = a.in[I_BADA][j0 + l];
#pragma unroll
            for (int w = 0; w < 8; ++w) s += red[(w * 4 + b) * 64 + l];
            mod[(size_t)b * NMOD + j0 + l] = s; }
        __syncthreads();
    }
    __syncthreads();
    LAS float* scr = (LAS float*)(X.lds + X.wave * 16384);
    const int gw = X.bx * 8 + X.wave, NGW = X.G * 8;
    constexpr int I_FIN = 32 * 352, I_FOUT = 88 * 64, I_MIX = 32 * 320, I_LR = 32, I_P = 16 * 64, I_MO = 32 * 64;
    constexpr int NITEMS = 2 * I_FIN + 2 * I_FOUT + I_MIX + I_LR + 2 * I_P + I_MO;
    for (int it = gw; it < NITEMS; it += NGW) {
        int r = it;
        if (r < 2 * I_FIN) { const int which = r >= I_FIN; r -= which * I_FIN; const int kb = r / 352, nb = r % 352, c0 = 32 * nb, bj = c0 / DFF, j = c0 % DFF;
            const int rd = 256 * (j / 128) + 128 * bj + (j % 128);
            if (rd < FIN_BF_TILES * 256) tr_item(a.in[which ? I_F2IN : I_F1IN], 2 * DFF, DM, 64 * kb, c0, (bf16_t*)(ws + (which ? WS_W2IN : WS_W1IN)), rd, 32, scr, X.lane);
            else tr_item8(a.in[which ? I_F2IN : I_F1IN], 2 * DFF, DM, 64 * kb, c0, ws + (which ? WS_W2IN8 : WS_W1IN8), rd - FIN_BF_TILES * 256, scr, X.lane);
            continue; }
        r -= 2 * I_FIN;
        if (r < 2 * I_FOUT) { const int which = r >= I_FOUT; r -= which * I_FOUT; const int kb = r / 64, nb = r % 64;
            tr_item(a.in[which ? I_F2OUT : I_F1OUT], DM, DFF, 64 * kb, 32 * nb, (bf16_t*)(ws + (which ? WS_W2OUT : WS_W1OUT)), 32 * nb, 32, scr, X.lane); continue; }
        r -= 2 * I_FOUT;
        if (r < I_MIX) { const int kb = r / 320, nb = r % 320, r0 = 32 * nb, c0 = r0 < 6144 ? r0 : r0 + 16;
            if (r0 < 6144) tr_item(a.in[I_WMIX], WMIX_SRC_LD, DM, 64 * kb, c0, (bf16_t*)(ws + WS_WMIX), r0, 32, scr, X.lane);
            else tr_item8(a.in[I_WMIX], WMIX_SRC_LD, DM, 64 * kb, c0, ws + WS_WG8, r0 - 6144, scr, X.lane);
            continue; }
        r -= I_MIX;
        if (r < I_LR) { tr_item(a.in[I_WMIX], WMIX_SRC_LD, DM, 64 * r, 6144, (bf16_t*)(ws + WS_WLR), 0, 16, scr, X.lane); continue; }
        r -= I_LR;
        if (r < 2 * I_P) { const int which = r >= I_P; r -= which * I_P; const int kb = r / 64, nb = r % 64;
            tr_item(a.in[which ? I_WPB : I_WPA], DM, 1024, 64 * kb, 32 * nb, (bf16_t*)(ws + (which ? WS_WPB : WS_WPA)), 32 * nb, 32, scr, X.lane); continue; }
        r -= 2 * I_P;
        { const int kb = r / 64, nb = r % 64; tr_item(a.in[I_WMO], DM, DM, 64 * kb, 32 * nb, (bf16_t*)(ws + WS_WMO), 32 * nb, 32, scr, X.lane); }
    }
}

__device__ __forceinline__ void p_modulate(const Ctx& X, const float* x, const float* mod, int sh_off, bf16_t* U, unsigned char* U8) {
    const size_t n8 = (size_t)M_TOK * DM / 8, stride = (size_t)X.G * 512;
    for (size_t i0 = (size_t)X.bx * 512 + X.tid; i0 < n8; i0 += 2 * stride) {
        const size_t i1 = i0 + stride; const bool two = i1 < n8;
        const int rowa = (int)(i0 >> 8), ca = (int)(i0 & 255) * 8, rowb = two ? (int)(i1 >> 8) : rowa, cb = two ? (int)(i1 & 255) * 8 : ca;
        const float* ma = mod + (size_t)(rowa >> 12) * NMOD + sh_off + ca; const float* mb = mod + (size_t)(rowb >> 12) * NMOD + sh_off + cb;
        const f32x4 xa0 = *(const f32x4*)(x + (size_t)rowa * DM + ca), xa1 = *(const f32x4*)(x + (size_t)rowa * DM + ca + 4), xb0 = *(const f32x4*)(x + (size_t)rowb * DM + cb), xb1 = *(const f32x4*)(x + (size_t)rowb * DM + cb + 4);
        const f32x4 sa0 = *(const f32x4*)(ma), sa1 = *(const f32x4*)(ma + 4), ka0 = *(const f32x4*)(ma + DM), ka1 = *(const f32x4*)(ma + DM + 4);
        const f32x4 sb0 = *(const f32x4*)(mb), sb1 = *(const f32x4*)(mb + 4), kb0 = *(const f32x4*)(mb + DM), kb1 = *(const f32x4*)(mb + DM + 4);
        { const f32x4 u0 = xa0 * (1.f + ka0) + sa0, u1 = xa1 * (1.f + ka1) + sa1;
          *(u32x4*)(U + (size_t)rowa * DM + ca) = pg8::pack8(u0, u1);
          u32x2 w8; w8.x = pk4_fp8(u0[0], u0[1], u0[2], u0[3]); w8.y = pk4_fp8(u1[0], u1[1], u1[2], u1[3]); *(u32x2*)(U8 + (size_t)rowa * DM + ca) = w8; }
        if (two) { const f32x4 u0 = xb0 * (1.f + kb0) + sb0, u1 = xb1 * (1.f + kb1) + sb1;
          *(u32x4*)(U + (size_t)rowb * DM + cb) = pg8::pack8(u0, u1);
          u32x2 w8; w8.x = pk4_fp8(u0[0], u0[1], u0[2], u0[3]); w8.y = pk4_fp8(u1[0], u1[1], u1[2], u1[3]); *(u32x2*)(U8 + (size_t)rowb * DM + cb) = w8; }
    }
}

template <bool LAST, bool F8 = false>
__device__ __forceinline__ void p_layernorm(const Ctx& X, const float* R, const float* lg, const float* lb, float* Hout, float* stats, const float* mod, int sh_off, bf16_t* U, unsigned char* U8 = nullptr) {
    const int gw = X.bx * 8 + X.wave, NGW = X.G * 8;
    for (int row = gw; row < M_TOK; row += NGW) {
        const float* rp = R + (size_t)row * DM + 4 * X.lane;
        f32x4 v[8]; float s = 0.f;
#pragma unroll
        for (int j = 0; j < 8; ++j) { v[j] = *(const f32x4*)(rp + 256 * j); s += (v[j][0] + v[j][1]) + (v[j][2] + v[j][3]); }
        const float mean = wave_sum(s) * (1.f / DM); float s2 = 0.f;
#pragma unroll
        for (int j = 0; j < 8; ++j) { v[j] = v[j] - mean; s2 += (v[j][0] * v[j][0] + v[j][1] * v[j][1]) + (v[j][2] * v[j][2] + v[j][3] * v[j][3]); }
        const float rstd = 1.f / sqrtf(wave_sum(s2) * (1.f / DM) + LN_EPS);
        const float* mp = LAST ? nullptr : mod + (size_t)(row >> 12) * NMOD + sh_off + 4 * X.lane;
        if constexpr (!LAST) { if (X.lane == 0) *(f32x2_t*)(stats + 2 * (size_t)row) = (f32x2_t){mean, rstd}; }
#pragma unroll
        for (int j = 0; j < 8; ++j) {
            const f32x4 g4 = *(const f32x4*)(lg + 4 * X.lane + 256 * j), b4 = *(const f32x4*)(lb + 4 * X.lane + 256 * j);
            const f32x4 y = v[j] * rstd * g4 + b4;
            if constexpr (LAST) *(f32x4*)(Hout + (size_t)row * DM + 4 * X.lane + 256 * j) = y;
            if constexpr (!LAST) { const f32x4 sh = *(const f32x4*)(mp + 256 * j), sc = *(const f32x4*)(mp + DM + 256 * j); const f32x4 uu = y * (1.f + sc) + sh;
                u32x2 w; w.x = cvt_pk_bf16(uu[0], uu[1]); w.y = cvt_pk_bf16(uu[2], uu[3]); *(u32x2*)(U + (size_t)row * DM + 4 * X.lane + 256 * j) = w;
                if constexpr (F8) *(unsigned*)(U8 + (size_t)row * DM + 4 * X.lane + 256 * j) = pk4_fp8(uu[0], uu[1], uu[2], uu[3]); }
        }
    }
}

__device__ __forceinline__ s16x4 tr_read(const LAS unsigned char* p) { return __builtin_bit_cast(s16x4, __builtin_amdgcn_ds_read_tr16_b64_v4i16((LAS s16x4*)p)); }
__device__ __forceinline__ bf16x8 cat8(s16x4 a, s16x4 b) { return (bf16x8){a[0], a[1], a[2], a[3], b[0], b[1], b[2], b[3]}; }

constexpr int KD_P = 1088, V_P = 576, OT_P = 528;
constexpr int L1_RED = 0, L1_LRS = 32768, L1_KD = 36864, L1_V = L1_KD + 64 * KD_P, L1_END = L1_V + 64 * V_P;
static_assert(L1_END <= 147456, "gla chunk LDS");

__device__ __forceinline__ void p_gla_chunk(const Ctx& X, const bf16_t* U, const bf16_t* WLR, const bf16_t* MIX, float* DEC, bf16_t* UB, const float* wa2, const float* bal) {
    LAS unsigned char* lds = X.lds;
    LAS float* red = (LAS float*)(lds + L1_RED);
    LAS float* lrs = (LAS float*)(lds + L1_LRS);
    const int tid = X.tid, lane = X.lane, w = X.wave, l15 = lane & 15, g = lane >> 4;
    const int tr_row = 8 * g + (l15 >> 2), tr_col = 4 * (l15 & 3);
    const int vr = tid >> 5, vc = tid & 31;
    for (int ch = X.bx; ch < 256; ch += X.G) {
        const size_t t0 = (size_t)ch * 64;
        f32x4 acc[4];
#pragma unroll
        for (int mi = 0; mi < 4; ++mi) acc[mi] = (f32x4){0.f, 0.f, 0.f, 0.f};
        const int kw = 256 * w + 8 * g;
#pragma unroll
        for (int s = 0; s < 8; ++s) {
            const bf16x8 bfr = *(const bf16x8*)(WLR + (size_t)l15 * DM + kw + 32 * s);
#pragma unroll
            for (int mi = 0; mi < 4; ++mi) { const bf16x8 afr = *(const bf16x8*)(U + (t0 + 16 * mi + l15) * DM + kw + 32 * s);
                acc[mi] = __builtin_amdgcn_mfma_f32_16x16x32_bf16(afr, bfr, acc[mi], 0, 0, 0); }
        }
#pragma unroll
        for (int mi = 0; mi < 4; ++mi)
#pragma unroll
            for (int e = 0; e < 4; ++e) red[(w * 64 + 16 * mi + 4 * g + e) * 16 + l15] = acc[mi][e];
        __syncthreads();
        for (int i = tid; i < 1024; i += 512) { float s = 0.f;
#pragma unroll
            for (int ww = 0; ww < 8; ++ww) s += red[ww * 1024 + i];
            lrs[i] = s; }
        __syncthreads();
        {   const int kp = tid;
            float wa[16];
#pragma unroll
            for (int r = 0; r < 16; ++r) wa[r] = wa2[r * 512 + kp];
            const float ba = bal[kp];
            float cum[64]; float run = 0.f;
#pragma unroll
            for (int c = 0; c < 64; ++c) {
                float z = ba;
#pragma unroll
                for (int r4 = 0; r4 < 4; ++r4) { const f32x4 l4 = *(const LAS f32x4*)(lrs + c * 16 + 4 * r4);
                    z += l4[0] * wa[4 * r4] + l4[1] * wa[4 * r4 + 1] + l4[2] * wa[4 * r4 + 2] + l4[3] * wa[4 * r4 + 3]; }
                const float ls = fminf(z, 0.f) - __logf(1.f + __expf(-fabsf(z)));
                run += ls * (1.f / 16.f); cum[c] = run;
            }
            DEC[(size_t)ch * 512 + kp] = __expf(run);
            const bf16_t* kptr = MIX + t0 * MIXP + C_KB + kp;
#pragma unroll
            for (int c = 0; c < 64; ++c) { const float kv = __uint_as_float((unsigned)kptr[(size_t)c * MIXP] << 16); const float kd = kv * __expf(run - cum[c]);
                *(LAS bf16_t*)(lds + L1_KD + c * KD_P + kp * 2) = (bf16_t)(cvt_pk_bf16(kd, 0.f) & 0xffffu); }
        }
        for (int h = 0; h < 4; ++h) {
            u32x4 pv[4];
#pragma unroll
            for (int i = 0; i < 4; ++i) pv[i] = *(const u32x4*)(MIX + (t0 + vr + 16 * i) * MIXP + C_VB + h * 256 + vc * 8);
            __syncthreads();
#pragma unroll
            for (int i = 0; i < 4; ++i) *(LAS u32x4*)(lds + L1_V + (vr + 16 * i) * V_P + vc * 16) = pv[i];
            __syncthreads();
            f32x4 uacc[2][8];
#pragma unroll
            for (int vt = 0; vt < 2; ++vt)
#pragma unroll
                for (int kt = 0; kt < 8; ++kt) uacc[vt][kt] = (f32x4){0.f, 0.f, 0.f, 0.f};
#pragma unroll
            for (int s = 0; s < 2; ++s) {
                bf16x8 va[2];
#pragma unroll
                for (int vt = 0; vt < 2; ++vt) { const LAS unsigned char* p = lds + L1_V + (32 * s + tr_row) * V_P + (32 * w + 16 * vt + tr_col) * 2; va[vt] = cat8(tr_read(p), tr_read(p + 4 * V_P)); }
#pragma unroll
                for (int kt = 0; kt < 8; ++kt) { const LAS unsigned char* p = lds + L1_KD + (32 * s + tr_row) * KD_P + (h * 128 + 16 * kt + tr_col) * 2;
                    const bf16x8 kf = cat8(tr_read(p), tr_read(p + 4 * KD_P));
                    uacc[0][kt] = __builtin_amdgcn_mfma_f32_16x16x32_bf16(va[0], kf, uacc[0][kt], 0, 0, 0);
                    uacc[1][kt] = __builtin_amdgcn_mfma_f32_16x16x32_bf16(va[1], kf, uacc[1][kt], 0, 0, 0); }
            }
            bf16_t* up = UB + ((size_t)(ch * 4 + h) * 128) * 256;
#pragma unroll
            for (int vt = 0; vt < 2; ++vt)
#pragma unroll
                for (int kt = 0; kt < 8; ++kt) { u32x2 o; o.x = cvt_pk_bf16(uacc[vt][kt][0], uacc[vt][kt][1]); o.y = cvt_pk_bf16(uacc[vt][kt][2], uacc[vt][kt][3]);
                    *(u32x2*)(up + (size_t)(16 * kt + l15) * 256 + 32 * w + 16 * vt + 4 * g) = o; }
        }
        __syncthreads();
    }
}

__device__ __forceinline__ void p_gla_scan_elem(const Ctx& X, const float* DEC, const bf16_t* UB, bf16_t* ST) {
    for (int idx = X.bx * 512 + X.tid; idx < 4 * 4 * 128 * 64; idx += X.G * 512) {
        const int vq = idx & 63, k = (idx >> 6) & 127, h = (idx >> 13) & 3, b = idx >> 15;
        const size_t off0 = ((size_t)((b * 64) * 4 + h) * 128 + k) * 256 + 4 * vq;
        const bf16_t* p0 = UB + off0; bf16_t* s0 = ST + off0;
        const float* d0 = DEC + (size_t)(b * 64) * 512 + h * 128 + k;
        f32x4 st = (f32x4){0.f, 0.f, 0.f, 0.f};
        for (int n8 = 0; n8 < 64; n8 += 8) {
            u32x2 uv[8]; float dv[8];
#pragma unroll
            for (int q = 0; q < 8; ++q) { uv[q] = *(const u32x2*)(p0 + (size_t)(n8 + q) * (4 * 128 * 256)); dv[q] = d0[(size_t)(n8 + q) * 512]; }
#pragma unroll
            for (int q = 0; q < 8; ++q) { const f32x4 uu = (f32x4){bf_lo(uv[q].x), bf_hi(uv[q].x), bf_lo(uv[q].y), bf_hi(uv[q].y)}; st = st * dv[q] + uu;
                u32x2 o; o.x = cvt_pk_bf16(st[0], st[1]); o.y = cvt_pk_bf16(st[2], st[3]); *(u32x2*)(s0 + (size_t)(n8 + q) * (4 * 128 * 256)) = o; }
        }
    }
}

constexpr int L3_S = 0, L3_SS = 128 * V_P, L3_OT = L3_SS + 2048, L3_END = L3_OT + 64 * OT_P;
static_assert(L3_END <= 131072, "gla readout LDS");
__device__ __forceinline__ void p_gla_readout(const Ctx& X, bf16_t* MIX, const bf16_t* UB, const float* gng) {
    LAS unsigned char* lds = X.lds;
    const int tid = X.tid, lane = X.lane, w = X.wave, l15 = lane & 15, g = lane >> 4;
    const int tr_row = 8 * g + (l15 >> 2), tr_col = 4 * (l15 & 3);
    const int vr = tid >> 5, vc = tid & 31;
    const float qscale = 0.08838834764831845f;
    for (int uid = X.bx; uid < 1024; uid += X.G) {
        const int ch = uid >> 2, h = uid & 3; const size_t t0 = (size_t)ch * 64;
        const bf16_t* sp = UB + ((size_t)(ch * 4 + h) * 128) * 256;
        u32x4 sv[8], rbv[4];
#pragma unroll
        for (int i = 0; i < 8; ++i) sv[i] = *(const u32x4*)(sp + (size_t)(vr + 16 * i) * 256 + vc * 8);
#pragma unroll
        for (int i = 0; i < 4; ++i) rbv[i] = *(const u32x4*)(MIX + (t0 + vr + 16 * i) * MIXP + C_RB + h * 256 + vc * 8);
        bf16x8 qf[4][4];
#pragma unroll
        for (int mc = 0; mc < 4; ++mc)
#pragma unroll
            for (int s = 0; s < 4; ++s) qf[mc][s] = *(const bf16x8*)(MIX + (t0 + 16 * mc + l15) * MIXP + C_QB + h * 128 + 32 * s + 8 * g);
#pragma unroll
        for (int i = 0; i < 8; ++i) *(LAS u32x4*)(lds + L3_S + (vr + 16 * i) * V_P + vc * 16) = sv[i];
        __syncthreads();
        f32x4 o[4][2];
#pragma unroll
        for (int mc = 0; mc < 4; ++mc) { o[mc][0] = (f32x4){0.f, 0.f, 0.f, 0.f}; o[mc][1] = (f32x4){0.f, 0.f, 0.f, 0.f}; }
#pragma unroll
        for (int s = 0; s < 4; ++s) {
            bf16x8 sb[2];
#pragma unroll
            for (int nt = 0; nt < 2; ++nt) { const LAS unsigned char* p = lds + L3_S + (32 * s + tr_row) * V_P + (32 * w + 16 * nt + tr_col) * 2; sb[nt] = cat8(tr_read(p), tr_read(p + 4 * V_P)); }
#pragma unroll
            for (int mc = 0; mc < 4; ++mc) { o[mc][0] = __builtin_amdgcn_mfma_f32_16x16x32_bf16(qf[mc][s], sb[0], o[mc][0], 0, 0, 0);
                o[mc][1] = __builtin_amdgcn_mfma_f32_16x16x32_bf16(qf[mc][s], sb[1], o[mc][1], 0, 0, 0); }
        }
#pragma unroll
        for (int mc = 0; mc < 4; ++mc) { f32x4 q2 = o[mc][0] * o[mc][0] + o[mc][1] * o[mc][1];
#pragma unroll
            for (int sh = 1; sh < 16; sh <<= 1) { q2[0] += __shfl_xor(q2[0], sh); q2[1] += __shfl_xor(q2[1], sh); q2[2] += __shfl_xor(q2[2], sh); q2[3] += __shfl_xor(q2[3], sh); }
            if (l15 == 0) *(LAS f32x4*)(lds + L3_SS + (w * 64 + 16 * mc + 4 * g) * 4) = q2; }
        __syncthreads();
#pragma unroll
        for (int mc = 0; mc < 4; ++mc) { f32x4 tot = (f32x4){0.f, 0.f, 0.f, 0.f};
#pragma unroll
            for (int ww = 0; ww < 8; ++ww) tot += *(const LAS f32x4*)(lds + L3_SS + (ww * 64 + 16 * mc + 4 * g) * 4);
#pragma unroll
            for (int e = 0; e < 4; ++e) { const float rs = qscale * __builtin_amdgcn_rsqf(tot[e] * (qscale * qscale / 256.f) + RMS_EPS);
#pragma unroll
                for (int nt = 0; nt < 2; ++nt) *(LAS bf16_t*)(lds + L3_OT + (16 * mc + 4 * g + e) * OT_P + (32 * w + 16 * nt + l15) * 2) = (bf16_t)(cvt_pk_bf16(o[mc][nt][e] * rs, 0.f) & 0xffffu); } }
        __syncthreads();
#pragma unroll
        for (int i = 0; i < 4; ++i) { const int row = vr + 16 * i; const u32x4 ot = *(const LAS u32x4*)(lds + L3_OT + row * OT_P + vc * 16);
            const f32x4 g0 = *(const f32x4*)(gng + vc * 8), g1 = *(const f32x4*)(gng + vc * 8 + 4); const u32x4 rb = rbv[i];
            f32x4 y0, y1;
            y0[0] = bf_lo(ot.x) * g0[0] * fast_silu(bf_lo(rb.x)); y0[1] = bf_hi(ot.x) * g0[1] * fast_silu(bf_hi(rb.x)); y0[2] = bf_lo(ot.y) * g0[2] * fast_silu(bf_lo(rb.y)); y0[3] = bf_hi(ot.y) * g0[3] * fast_silu(bf_hi(rb.y));
            y1[0] = bf_lo(ot.z) * g1[0] * fast_silu(bf_lo(rb.z)); y1[1] = bf_hi(ot.z) * g1[1] * fast_silu(bf_hi(rb.z)); y1[2] = bf_lo(ot.w) * g1[2] * fast_silu(bf_lo(rb.w)); y1[3] = bf_hi(ot.w) * g1[3] * fast_silu(bf_hi(rb.w));
            *(u32x4*)(MIX + (t0 + row) * MIXP + C_RB + h * 256 + vc * 8) = pg8::pack8(y0, y1); }
    }
}

__device__ __forceinline__ int crow(int r, int hi) { return (r & 3) + 8 * (r >> 2) + 4 * hi; }
constexpr int AV_P = 192, A_WAVE_BYTES = 64 * AV_P + 256, L_ABIAS = 8 * A_WAVE_BYTES;
static_assert(L_ABIAS + 16 * 320 * 4 <= 131072, "attention LDS");

__device__ __forceinline__ void attn_unit(const Ctx& X, bf16_t* MIX, int b, int h, int n, int half) {
    const int lane = X.lane, r32 = lane & 31, hi = lane >> 5;
    LAS unsigned char* wl = X.lds + X.wave * A_WAVE_BYTES;
    LAS float* wsf = (LAS float*)(wl + 64 * AV_P);
    const LAS float* bias2 = (const LAS float*)(X.lds + L_ABIAS) + h * 320;
    const size_t trow0 = (size_t)b * SEQ + n * 64 + half * 32;
    bf16x8 qr[4];
    { const bf16_t* Qp = MIX + (trow0 + r32) * MIXP + C_QA + h * 64 + hi * 8;
#pragma unroll
      for (int d0 = 0; d0 < 4; ++d0) qr[d0] = *(const bf16x8*)(Qp + d0 * 16); }
    f32x16 o0, o1;
#pragma unroll
    for (int r = 0; r < 16; ++r) { o0[r] = 0.f; o1[r] = 0.f; }
    float mrun = -1e30f, lrun = 0.f;
    const int vbase = (4 * hi + ((lane & 15) >> 2)) * AV_P + (16 * ((lane >> 4) & 1) + 4 * (lane & 3)) * 2;
    const float sc2 = 0.125f * LOG2E;
    const int j0 = (n >= 8 ? 0 : 8 - n);
    bf16x8 k0[4], k1[4]; u32x4 vv[8];
#define ATT_LOAD(j_) do { const size_t kv0_ = (size_t)b * SEQ + (size_t)(n - 8 + (j_)) * 64; \
        const bf16_t* Kp_ = MIX + (kv0_ + r32) * MIXP + C_KA + h * 64 + hi * 8; \
        _Pragma("unroll") for (int d0 = 0; d0 < 4; ++d0) { k0[d0] = *(const bf16x8*)(Kp_ + d0 * 16); k1[d0] = *(const bf16x8*)(Kp_ + (size_t)32 * MIXP + d0 * 16); } \
        const bf16_t* Vp_ = MIX + (kv0_ + (lane >> 3)) * MIXP + C_VA + h * 64 + (lane & 7) * 8; \
        _Pragma("unroll") for (int i = 0; i < 8; ++i) vv[i] = *(const u32x4*)(Vp_ + (size_t)(8 * i) * MIXP); } while (0)
    ATT_LOAD(j0);
    for (int j = j0; j < 9; ++j) {
#pragma unroll
        for (int i = 0; i < 8; ++i) *(LAS u32x4*)(wl + (8 * i + (lane >> 3)) * AV_P + (lane & 7) * 16) = vv[i];
        bf16x8 kc0[4], kc1[4];
#pragma unroll
        for (int d0 = 0; d0 < 4; ++d0) { kc0[d0] = k0[d0]; kc1[d0] = k1[d0]; }
        if (j + 1 < 9) ATT_LOAD(j + 1);
        f32x16 p0, p1;
#pragma unroll
        for (int r = 0; r < 16; ++r) { p0[r] = 0.f; p1[r] = 0.f; }
#pragma unroll
        for (int d0 = 0; d0 < 4; ++d0) { p0 = __builtin_amdgcn_mfma_f32_32x32x16_bf16(kc0[d0], qr[d0], p0, 0, 0, 0); p1 = __builtin_amdgcn_mfma_f32_32x32x16_bf16(kc1[d0], qr[d0], p1, 0, 0, 0); }
        if (j <= 3) { const float bc = bias2[0];
#pragma unroll
            for (int r = 0; r < 16; ++r) { p0[r] = p0[r] * sc2 + bc; p1[r] = p1[r] * sc2 + bc; }
        } else { const int rb = (j - 8) * 64 - (32 * half + r32) + 4 * hi + 256;
#pragma unroll
            for (int r = 0; r < 16; ++r) { const int c = (r & 3) + 8 * (r >> 2); const int i0 = max(rb + c, 0), i1 = max(rb + c + 32, 0);
                p0[r] = p0[r] * sc2 + bias2[i0]; p1[r] = p1[r] * sc2 + bias2[i1]; }
        }
        float mx = fmaxf(p0[0], p1[0]);
#pragma unroll
        for (int r = 1; r < 16; ++r) mx = fmaxf(mx, fmaxf(p0[r], p1[r]));
        mx = fmaxf(mx, __shfl_xor(mx, 32));
        const float mnew = fmaxf(mrun, mx), alpha = __builtin_amdgcn_exp2f(mrun - mnew); mrun = mnew;
        float rs = 0.f;
#pragma unroll
        for (int r = 0; r < 16; ++r) { p0[r] = __builtin_amdgcn_exp2f(p0[r] - mnew); p1[r] = __builtin_amdgcn_exp2f(p1[r] - mnew); rs += p0[r] + p1[r]; }
        lrun = lrun * alpha + rs;
        if (!__all(alpha == 1.0f)) {
        wsf[r32] = alpha;
#pragma unroll
        for (int g4 = 0; g4 < 4; ++g4) { const f32x4 a4 = *(const LAS f32x4*)(wsf + 8 * g4 + 4 * hi);
#pragma unroll
            for (int e = 0; e < 4; ++e) { o0[4 * g4 + e] *= a4[e]; o1[4 * g4 + e] *= a4[e]; } }
        }
        bf16x8 pa[4];
        { u32x4 t;
          t.x = cvt_pk_bf16(p0[0], p0[1]); t.y = cvt_pk_bf16(p0[2], p0[3]); t.z = cvt_pk_bf16(p0[4], p0[5]); t.w = cvt_pk_bf16(p0[6], p0[7]); pa[0] = __builtin_bit_cast(bf16x8, t);
          t.x = cvt_pk_bf16(p0[8], p0[9]); t.y = cvt_pk_bf16(p0[10], p0[11]); t.z = cvt_pk_bf16(p0[12], p0[13]); t.w = cvt_pk_bf16(p0[14], p0[15]); pa[1] = __builtin_bit_cast(bf16x8, t);
          t.x = cvt_pk_bf16(p1[0], p1[1]); t.y = cvt_pk_bf16(p1[2], p1[3]); t.z = cvt_pk_bf16(p1[4], p1[5]); t.w = cvt_pk_bf16(p1[6], p1[7]); pa[2] = __builtin_bit_cast(bf16x8, t);
          t.x = cvt_pk_bf16(p1[8], p1[9]); t.y = cvt_pk_bf16(p1[10], p1[11]); t.z = cvt_pk_bf16(p1[12], p1[13]); t.w = cvt_pk_bf16(p1[14], p1[15]); pa[3] = __builtin_bit_cast(bf16x8, t); }
#pragma unroll
        for (int kk = 0; kk < 4; ++kk) { const LAS unsigned char* p = wl + vbase + (16 * kk) * AV_P;
            const bf16x8 v0 = cat8(tr_read(p), tr_read(p + 8 * AV_P)), v1 = cat8(tr_read(p + 64), tr_read(p + 8 * AV_P + 64));
            o0 = __builtin_amdgcn_mfma_f32_32x32x16_bf16(pa[kk], v0, o0, 0, 0, 0);
            o1 = __builtin_amdgcn_mfma_f32_32x32x16_bf16(pa[kk], v1, o1, 0, 0, 0); }
    }
#undef ATT_LOAD
    lrun += __shfl_xor(lrun, 32);
    wsf[r32] = 1.f / lrun;
#pragma unroll
    for (int g4 = 0; g4 < 4; ++g4) { const f32x4 a4 = *(const LAS f32x4*)(wsf + 8 * g4 + 4 * hi);
#pragma unroll
        for (int e = 0; e < 4; ++e) { const int q = 8 * g4 + 4 * hi + e;
            *(LAS bf16_t*)(wl + q * 144 + r32 * 2) = (bf16_t)(cvt_pk_bf16(o0[4 * g4 + e] * a4[e], 0.f) & 0xffffu);
            *(LAS bf16_t*)(wl + q * 144 + 64 + r32 * 2) = (bf16_t)(cvt_pk_bf16(o1[4 * g4 + e] * a4[e], 0.f) & 0xffffu); } }
#pragma unroll
    for (int i = 0; i < 4; ++i) { const int row = 8 * i + (lane >> 3), chn = lane & 7; const u32x4 v = *(const LAS u32x4*)(wl + row * 144 + chn * 16);
        *(u32x4*)(MIX + (trow0 + row) * MIXP + C_QA + h * 64 + chn * 8) = v; }
}


#define XB_TMO      128
#define XB_XCNT(j)  (256  + 64 * (j))
#define XB_XSUB(j)  (1280 + 64 * (j))
#define XB_XGEN(j)  (2304 + 64 * (j))
#define XB_TOP      3328
#define XB_TOPGEN   3392
#define XCD_BAR_WORDS 3456
#define XB_SPIN_CAP (1u << 18)
__device__ __forceinline__ unsigned xb_ld(unsigned* p)              { return __hip_atomic_load(p, __ATOMIC_RELAXED, __HIP_MEMORY_SCOPE_AGENT); }
__device__ __forceinline__ unsigned xb_add(unsigned* p, unsigned v) { return __hip_atomic_fetch_add(p, v, __ATOMIC_RELAXED, __HIP_MEMORY_SCOPE_AGENT); }
__device__ __forceinline__ unsigned xb_xcc_id() { return (unsigned)__builtin_amdgcn_s_getreg((3 << 11) | 20) & 0xFu; }
#define XB_SPIN(cond, bar) do { unsigned _sp = 0; while (cond) { __builtin_amdgcn_s_sleep(1); \
    if ((++_sp & 255u) == 0u) { if (xb_ld(&(bar)[XB_TMO])) break; if (_sp > XB_SPIN_CAP) { atomicAdd(&(bar)[XB_TMO], 1u); break; } } } } while (0)
struct XcdBarrier { unsigned* bar; unsigned x; volatile LAS unsigned* st; };
__device__ __forceinline__ XcdBarrier xcd_barrier_post(unsigned* bar, volatile LAS unsigned* st) {
    XcdBarrier b; b.bar = bar; b.x = xb_xcc_id(); b.st = st;
    if (threadIdx.x == 0) (void)xb_add(&bar[XB_XCNT(b.x)], 1u);
    return b;
}
__device__ __forceinline__ void xcd_barrier_complete(unsigned* bar, unsigned x, unsigned& nloc, unsigned& nx) {
    const unsigned G = gridDim.x * gridDim.y * gridDim.z;
    unsigned sum, cnt, mine, sp = 0u;
    for (;;) {
        sum = 0u; cnt = 0u; mine = 0u;
#pragma unroll
        for (unsigned j = 0; j < 16; ++j) { const unsigned c = xb_ld(&bar[XB_XCNT(j)]); sum += c; cnt += (c > 0u) ? 1u : 0u; mine = (j == x) ? c : mine; }
        if (sum == G) break;
        __builtin_amdgcn_s_sleep(1);
        if ((++sp & 255u) == 0u) { if (xb_ld(&bar[XB_TMO])) break; if (sp > XB_SPIN_CAP) { atomicAdd(&bar[XB_TMO], 1u); break; } }
    }
    nloc = mine > 0u ? mine : 1u; nx = cnt > 0u ? cnt : 1u;
}
__device__ __forceinline__ void xcd_barrier(const XcdBarrier& b) {
    asm volatile("s_waitcnt vmcnt(0)" ::: "memory");
    __syncthreads();
    if (threadIdx.x == 0) {
        unsigned* bar = b.bar;
        __builtin_amdgcn_s_waitcnt(0);
        unsigned nloc = b.st[0], nx = b.st[1];
        if (nloc == 0u) { xcd_barrier_complete(bar, b.x, nloc, nx); b.st[0] = nloc; b.st[1] = nx; }
        const unsigned old = xb_add(&bar[XB_XSUB(b.x)], 1u);
        const unsigned gen = old / nloc;
        if (old + 1u == (gen + 1u) * nloc) {
            __builtin_amdgcn_fence(__ATOMIC_RELEASE, "agent");
            asm volatile("s_waitcnt vmcnt(0)" ::: "memory");
            const unsigned og = xb_add(&bar[XB_TOP], 1u);
            const unsigned tg = og / nx;
            if (og + 1u == (tg + 1u) * nx) xb_add(&bar[XB_TOPGEN], 1u);
            else XB_SPIN(xb_ld(&bar[XB_TOPGEN]) == tg, bar);
            __builtin_amdgcn_fence(__ATOMIC_ACQUIRE, "agent");
            xb_add(&bar[XB_XGEN(b.x)], 1u);
            asm volatile("s_waitcnt vmcnt(0)" ::: "memory");
        } else {
            XB_SPIN(xb_ld(&bar[XB_XGEN(b.x)]) == gen, bar);
            __builtin_amdgcn_fence(__ATOMIC_ACQUIRE, "agent");
            asm volatile("s_waitcnt vmcnt(0)" ::: "memory");
        }
    }
    __syncthreads();
}

__global__ void __launch_bounds__(512, 2) fwd_megakernel(Args args) {
    extern __shared__ __attribute__((aligned(16))) unsigned char lds_raw[];
    Ctx X; X.lds = (LAS unsigned char*)lds_raw; X.tid = threadIdx.x; X.lane = X.tid & 63; X.wave = __builtin_amdgcn_readfirstlane(X.tid >> 6); X.G = gridDim.x; X.bx = blockIdx.x; X.a = &args;
    unsigned char* ws = args.ws;
    float* mod = (float*)(ws + WS_MOD); float* DEC = (float*)(ws + WS_DEC);
    bf16_t* W1IN = (bf16_t*)(ws + WS_W1IN); bf16_t* W1OUT = (bf16_t*)(ws + WS_W1OUT); bf16_t* WMIX = (bf16_t*)(ws + WS_WMIX); bf16_t* WLR = (bf16_t*)(ws + WS_WLR);
    bf16_t* WPA = (bf16_t*)(ws + WS_WPA); bf16_t* WPB = (bf16_t*)(ws + WS_WPB); bf16_t* WMO = (bf16_t*)(ws + WS_WMO); bf16_t* W2IN = (bf16_t*)(ws + WS_W2IN); bf16_t* W2OUT = (bf16_t*)(ws + WS_W2OUT);
    bf16_t* U = (bf16_t*)(ws + WS_U); float* H = (float*)(ws + WS_H); bf16_t* ACT = (bf16_t*)(ws + WS_BIG); bf16_t* MIX = (bf16_t*)(ws + WS_BIG); bf16_t* UB = (bf16_t*)(ws + WS_UB); unsigned char* U8 = ws + WS_UB;     bf16_t* ST = (bf16_t*)(ws + WS_W1IN);
    float* R = args.out; bf16_t* GATES = (bf16_t*)(ws + WS_H); float* STATS = (float*)(ws + WS_STAT);
    const int lo = args.ph_lo, hi = args.ph_hi;
    cg::grid_group grid = cg::this_grid();
    volatile LAS unsigned* MISC = (volatile LAS unsigned*)(X.lds + LDS_MISC);
    if (X.tid < 16) MISC[X.tid] = 0u;
    __syncthreads();
    XcdBarrier bar; bar.bar = (unsigned*)(ws + WS_BAR); bar.x = 0; bar.st = nullptr;
    if (hi - lo > 1) { bar = xcd_barrier_post((unsigned*)(ws + WS_BAR), MISC); grid.sync(); }
#define NREP(k) (1 + ((PROBE_DUP >> (k)) & 1))
#define PHASE(k, ...) if (lo <= (k) && (k) < hi) { __VA_ARGS__ if (NREP(k) == 2) { xcd_barrier(bar); __VA_ARGS__ } }
#define SEAM(k) do { if (lo <= (k) && (k) + 1 < hi) xcd_barrier(bar); } while (0)

    PHASE(0, { p0_prologue(X); }) SEAM(0);
    PHASE(1, { p_modulate(X, args.in[I_X], mod, 0, U, U8); }) SEAM(1);
    PHASE(2, { { pg8::Gemm g{U, W1IN, M_TOK, FIN_BF_TILES * 256, DM, DM}; pg8::StaticOrder S; S.init(M_TOK, FIN_BF_TILES * 256, X.G, X.bx); pg8::EpiSwiglu<false> E{ACT};
          pg8::gemm_phase<pg8::EpiSwiglu<false>, pg8::StaticOrder, true>(X.lds, g, S, E); }
        { pg8::Gemm g{(const bf16_t*)U8, (const bf16_t*)(ws + WS_W1IN8), M_TOK, (44 - FIN_BF_TILES) * 256, DM, DM}; pg8::StaticOrder S; S.init(M_TOK, (44 - FIN_BF_TILES) * 256, X.G, X.bx); pg8::EpiSwiglu<true> E{ACT};
          pg8::gemm_phase<pg8::EpiSwiglu<true>, pg8::StaticOrder, true, true>(X.lds, g, S, E); } }) SEAM(2);
    PHASE(3, { pg8::Gemm g{ACT, W1OUT, M_TOK, DM, DFF, DFF}; pg8::StaticOrder S; S.init(M_TOK, DM, X.G, X.bx); pg8::EpiResidT<false> E{args.in[I_X], R, mod + 2 * DM, 0.5f, nullptr, nullptr, nullptr};
        pg8::gemm_phase<pg8::EpiResidT<false>, pg8::StaticOrder, ALIGN2>(X.lds, g, S, E); }) SEAM(3);
    PHASE(4, { p_layernorm<false, true>(X, R, args.in[I_LN1G], args.in[I_LN1B], nullptr, STATS, mod, 3 * DM, U, U8); }) SEAM(4);
    PHASE(5, { { pg8::Gemm g{U, WMIX, M_TOK, 6144, DM, DM}; pg8::StaticOrder S; S.init(M_TOK, 6144, X.G, X.bx); pg8::EpiMix E{MIX, GATES};
          pg8::gemm_phase<pg8::EpiMix, pg8::StaticOrder, true>(X.lds, g, S, E); }
        { pg8::Gemm g{(const bf16_t*)U8, (const bf16_t*)(ws + WS_WG8), M_TOK, 4096, DM, DM}; pg8::StaticOrder S; S.init(M_TOK, 4096, X.G, X.bx); pg8::EpiGates8 E{GATES};
          pg8::gemm_phase<pg8::EpiGates8, pg8::StaticOrder, true, true>(X.lds, g, S, E); } }) SEAM(5);
    PHASE(6, {
        p_gla_chunk(X, U, WLR, MIX, DEC, UB, args.in[I_WA2], args.in[I_BAL]);
        LAS float* bt = (LAS float*)(X.lds + L_ABIAS);
        for (int i = X.tid; i < 16 * 320; i += 512) bt[i] = args.in[I_RELB][i] * LOG2E;
        __syncthreads();
        for (int uid = X.bx * 8 + X.wave; uid < 8192; uid += X.G * 8) { const int half = uid & 1, n = (uid >> 1) & 63, bh = uid >> 7; attn_unit(X, MIX, bh >> 4, bh & 15, n, half); }
    }) SEAM(6);
    PHASE(7, { p_gla_scan_elem(X, DEC, UB, ST); }) SEAM(7);
    PHASE(8, { p_gla_readout(X, MIX, ST, args.in[I_GNG]); }) SEAM(8);
    PHASE(9, { pg8::Gemm g{MIX + C_QA, WPA, M_TOK, DM, 1024, MIXP}; pg8::StaticOrder S; S.init(M_TOK, DM, X.G, X.bx); pg8::EpiGate<false> E{GATES, U, nullptr};
        pg8::gemm_phase<pg8::EpiGate<false>, pg8::StaticOrder, true>(X.lds, g, S, E); asm volatile("s_waitcnt vmcnt(0)" ::: "memory"); __syncthreads(); })
    PHASE(10, { pg8::Gemm g{MIX + C_RB, WPB, M_TOK, DM, 1024, MIXP}; pg8::StaticOrder S; S.init(M_TOK, DM, X.G, X.bx); pg8::EpiGate<true> E{GATES + 2048, U, MIX + C_MERGED};
        pg8::gemm_phase<pg8::EpiGate<true>, pg8::StaticOrder, true>(X.lds, g, S, E); }) SEAM(10);
    PHASE(11, { pg8::Gemm g{MIX + C_MERGED, WMO, M_TOK, DM, DM, MIXP}; pg8::StaticOrder S; S.init(M_TOK, DM, X.G, X.bx); pg8::EpiResidT<true> E{R, R, mod + 5 * DM, 1.0f, STATS, args.in[I_LN1G], args.in[I_LN1B]};
        pg8::gemm_phase<pg8::EpiResidT<true>, pg8::StaticOrder, ALIGN2>(X.lds, g, S, E); }) SEAM(11);
    PHASE(12, { p_layernorm<false, true>(X, R, args.in[I_LN2G], args.in[I_LN2B], nullptr, STATS, mod, 6 * DM, U, U8); }) SEAM(12);
    PHASE(13, { { pg8::Gemm g{U, W2IN, M_TOK, FIN_BF_TILES * 256, DM, DM}; pg8::StaticOrder S; S.init(M_TOK, FIN_BF_TILES * 256, X.G, X.bx); pg8::EpiSwiglu<false> E{ACT};
          pg8::gemm_phase<pg8::EpiSwiglu<false>, pg8::StaticOrder, true>(X.lds, g, S, E); }
        { pg8::Gemm g{(const bf16_t*)U8, (const bf16_t*)(ws + WS_W2IN8), M_TOK, (44 - FIN_BF_TILES) * 256, DM, DM}; pg8::StaticOrder S; S.init(M_TOK, (44 - FIN_BF_TILES) * 256, X.G, X.bx); pg8::EpiSwiglu<true> E{ACT};
          pg8::gemm_phase<pg8::EpiSwiglu<true>, pg8::StaticOrder, true, true>(X.lds, g, S, E); } }) SEAM(13);
    PHASE(14, { pg8::Gemm g{ACT, W2OUT, M_TOK, DM, DFF, DFF}; pg8::StaticOrder S; S.init(M_TOK, DM, X.G, X.bx); pg8::EpiResidT<true> E{R, R, mod + 8 * DM, 0.5f, STATS, args.in[I_LN2G], args.in[I_LN2B]};
        pg8::gemm_phase<pg8::EpiResidT<true>, pg8::StaticOrder, ALIGN2>(X.lds, g, S, E); }) SEAM(14);
    PHASE(15, { p_layernorm<true>(X, R, args.in[I_LN3G], args.in[I_LN3B], R, nullptr, nullptr, 0, nullptr); })
#undef PHASE
#undef SEAM
}

constexpr int N_PHASES = 16;

extern "C" void kernel_launch(void* const* d_in, const int* in_sizes, int n_in, void* d_out, int out_size, void* d_ws, size_t ws_size, hipStream_t stream) {
    static int grid = 0;
    if (grid == 0) {
        if (n_in != 22 || out_size != M_TOK * DM || ws_size < WS_END) { fprintf(stderr, "kernel_launch: unexpected shapes (n_in %d, out %d, ws %zu < %zu)\n", n_in, out_size, ws_size, (size_t)WS_END); grid = -1; return; }
        int dev = 0, cus = 0, per_cu = 0;
        (void)hipGetDevice(&dev); (void)hipDeviceGetAttribute(&cus, hipDeviceAttributeMultiprocessorCount, dev);
        if (hipFuncSetAttribute((const void*)fwd_megakernel, hipFuncAttributeMaxDynamicSharedMemorySize, LDS_BYTES) != hipSuccess) { fprintf(stderr, "kernel_launch: hipFuncSetAttribute failed\n"); grid = -1; return; }
        if (hipOccupancyMaxActiveBlocksPerMultiprocessor(&per_cu, (const void*)fwd_megakernel, 512, LDS_BYTES) != hipSuccess || per_cu < 1) { fprintf(stderr, "kernel_launch: occupancy query says %d\n", per_cu); per_cu = 1; }
        (void)hipGetLastError();
        grid = cus > 0 ? cus : 256;
    }
    if (grid < 0) return;
    if (hipMemsetAsync((char*)d_ws + WS_BAR, 0, BAR_BYTES, stream) != hipSuccess) { fprintf(stderr, "kernel_launch: memset of the barrier words failed\n"); return; }
    Args a{};
    for (int i = 0; i < 22; ++i) a.in[i] = (const float*)d_in[i];
    a.out = (float*)d_out; a.ws = (unsigned char*)d_ws;
#if MK_COOP
    a.ph_lo = 0; a.ph_hi = N_PHASES;
    void* kargs[] = {&a};
    hipError_t e = hipLaunchCooperativeKernel((const void*)fwd_megakernel, dim3(grid), dim3(512), kargs, LDS_BYTES, stream);
    if (e != hipSuccess) fprintf(stderr, "kernel_launch: cooperative launch failed: %s (grid %d)\n", hipGetErrorString(e), grid);
#else
    for (int ph = 0; ph < N_PHASES; ++ph) { a.ph_lo = ph; a.ph_hi = ph + 1; hipLaunchKernelGGL(fwd_megakernel, dim3(grid), dim3(512), LDS_BYTES, stream, a); }
#endif
}
```

```cpp
#include <hip/hip_runtime.h>
#include <hip/hip_cooperative_groups.h>
#include <cstdio>
#include <cstdint>
namespace cg = cooperative_groups;

#ifndef MK_COOP
#define MK_COOP 1
#endif

#ifndef ALIGN2
#define ALIGN2 false
#endif
#ifndef PROBE_DUP
#define PROBE_DUP 0
#endif

#define LAS __attribute__((address_space(3)))
typedef unsigned short bf16_t;
typedef short bf16x8 __attribute__((ext_vector_type(8)));
typedef float f32x4 __attribute__((ext_vector_type(4)));
typedef float f32x16 __attribute__((ext_vector_type(16)));
typedef unsigned u32x4 __attribute__((ext_vector_type(4)));
typedef unsigned u32x2 __attribute__((ext_vector_type(2)));
typedef short s16x4 __attribute__((ext_vector_type(4)));
typedef int i32x4 __attribute__((ext_vector_type(4)));
typedef int i32x8 __attribute__((ext_vector_type(8)));
constexpr int FIN_BF_TILES = 36;
constexpr float G8_SCALE = 64.f;

constexpr int M_TOK = 16384, DM = 2048, DFF = 5632, SEQ = 4096, NMOD = 18432;
constexpr int MIXP = 6144;
constexpr int GP = 4096;
constexpr int C_QA = 0, C_KA = 1024, C_VA = 2048, C_QB = 3072, C_KB = 3584, C_VB = 4096, C_RB = 5120, C_MERGED = 1024;
constexpr int WMIX_SRC_LD = 10256;
constexpr float ALPHA = 1.189207115002721f;
constexpr float LN_EPS = 1e-5f, RMS_EPS = 1e-6f;
constexpr float LOG2E = 1.4426950408889634f;

constexpr size_t MiB = 1u << 20;
constexpr size_t WS_BAR = 320 * 1024, BAR_BYTES = 16384;
constexpr size_t WS_STAT = 336 * 1024;
constexpr size_t WS_MOD = 4096;
constexpr size_t WS_DEC = 512 * 1024;
constexpr size_t WS_W1IN = 1 * MiB, WS_W1OUT = 45 * MiB, WS_WMIX = 67 * MiB, WS_WLR = 107 * MiB, WS_WPA = 108 * MiB, WS_WPB = 112 * MiB,
                 WS_WMO = 116 * MiB, WS_W2IN = 124 * MiB, WS_W2OUT = 168 * MiB, WS_U = 190 * MiB, WS_H = 254 * MiB, WS_BIG = 382 * MiB, WS_UB = 574 * MiB, WS_W1IN8 = 638 * MiB, WS_W2IN8 = 642 * MiB, WS_END = 646 * MiB;

constexpr size_t WS_WG8 = 91 * MiB;
constexpr int LDS_MISC = 147456 - 64;
constexpr int LDS_BYTES = 147456;

typedef float f32x2_t __attribute__((ext_vector_type(2))); typedef __bf16 bf16x2_t __attribute__((ext_vector_type(2)));
__device__ __forceinline__ unsigned cvt_pk_bf16(float lo, float hi) { const f32x2_t v = {lo, hi}; const bf16x2_t b = __builtin_convertvector(v, bf16x2_t); return __builtin_bit_cast(unsigned, b); }
__device__ __forceinline__ float bf_lo(unsigned w) { return __uint_as_float(w << 16); }
__device__ __forceinline__ float bf_hi(unsigned w) { return __uint_as_float(w & 0xffff0000u); }
__device__ __forceinline__ float fast_sigmoid(float x) { return __builtin_amdgcn_rcpf(1.f + __builtin_amdgcn_exp2f(-LOG2E * x)); }
__device__ __forceinline__ float fast_silu(float x) { return x * fast_sigmoid(x); }
__device__ __forceinline__ f32x2_t sigmoid_pk(f32x2_t x) { const f32x2_t t = x * (-LOG2E); f32x2_t e; e[0] = __builtin_amdgcn_exp2f(t[0]); e[1] = __builtin_amdgcn_exp2f(t[1]);
    const f32x2_t d = e + 1.0f; f32x2_t r; r[0] = __builtin_amdgcn_rcpf(d[0]); r[1] = __builtin_amdgcn_rcpf(d[1]); return r; }
template <bool F8> __device__ __forceinline__ f32x2_t sigmoid_sc_pk(f32x2_t x) { constexpr float k = F8 ? -LOG2E / 64.f : -LOG2E; const f32x2_t t = x * k; f32x2_t e; e[0] = __builtin_amdgcn_exp2f(t[0]); e[1] = __builtin_amdgcn_exp2f(t[1]);
    const f32x2_t d = e + 1.0f; f32x2_t r; r[0] = __builtin_amdgcn_rcpf(d[0]); r[1] = __builtin_amdgcn_rcpf(d[1]); return r; }
template <bool F8> __device__ __forceinline__ f32x4 swiglu_pk4(f32x4 a, f32x4 b) { const f32x2_t a0 = {a[0], a[1]}, a1 = {a[2], a[3]}, b0 = {b[0], b[1]}, b1 = {b[2], b[3]};
    constexpr float s2 = F8 ? 1.f / (64.f * 64.f) : 1.f;
    f32x2_t o0 = (a0 * b0) * sigmoid_sc_pk<F8>(a0), o1 = (a1 * b1) * sigmoid_sc_pk<F8>(a1); if constexpr (F8) { o0 = o0 * s2; o1 = o1 * s2; } return (f32x4){o0[0], o0[1], o1[0], o1[1]}; }
__device__ __forceinline__ f32x4 gate_pk4(f32x4 v, unsigned glo, unsigned ghi) {
    const f32x2_t g0 = {__uint_as_float(glo << 16), __uint_as_float(glo & 0xffff0000u)}, g1 = {__uint_as_float(ghi << 16), __uint_as_float(ghi & 0xffff0000u)};
    const f32x2_t v0 = {v[0], v[1]}, v1 = {v[2], v[3]}; const f32x2_t o0 = v0 * sigmoid_pk(g0), o1 = v1 * sigmoid_pk(g1); return (f32x4){o0[0], o0[1], o1[0], o1[1]}; }
__device__ __forceinline__ float wave_sum(float v) {
#pragma unroll
    for (int o = 1; o < 64; o <<= 1) v += __shfl_xor(v, o);
    return v;
}

namespace pg8 {
constexpr int BM = 256, BK = 64, HALF = 128, HTB = HALF * BK * 2, STAGE_BYTES = 8 * HTB, NXCD = 8, WGM = 8;
__host__ __device__ __forceinline__ int lds_byte(int r, int c) { const int st = (r >> 4) * 2 + (c >> 5), rr = r & 15, cc = c & 31, ob = rr * 64 + cc * 2; return st * 1024 + (ob ^ (((ob >> 9) & 1) << 5)); }
__host__ __device__ __forceinline__ void stage_rc(int b, int& R, int& C) { const int st = b / 1024, sb = b % 1024, swz = sb ^ (((sb >> 9) & 1) << 5); R = (st >> 1) * 16 + swz / 64; C = (st & 1) * 32 + (swz % 64) / 2; }
__host__ __device__ __forceinline__ int perm32(int rho) { const int n = rho >> 4, i = rho & 15; return 8 * (i >> 2) + 4 * n + (i & 3); }

struct Unit { int pm, pn; };
struct Gemm { const bf16_t* A; const bf16_t* Bt; int M, N, K, lda; };

struct StaticOrder {
    int nM, nN, nwg, G, c;
    __host__ __device__ void init(int M, int N, int G_, int c_) { nM = M / BM; nN = N / BM; nwg = nM * nN; G = G_; c = c_; }
    __host__ __device__ bool next(int i, Unit& u) const {
        const long L = (long)i * G + c; if (L >= nwg) return false;
        int wgid = (int)L; { const int q = nwg / NXCD, r = nwg % NXCD, xcd = wgid % NXCD, off = wgid / NXCD; wgid = (xcd < r ? xcd * (q + 1) : r * (q + 1) + (xcd - r) * q) + off; }
        const int nig = WGM * nN, gid = wgid / nig, fm = gid * WGM, gsz = (nM - fm) < WGM ? (nM - fm) : WGM;
        u.pm = fm + ((wgid % nig) % gsz); u.pn = (wgid % nig) / gsz; return true;
    }
};

template <class Epi, class Sched, bool ALIGN_EPI, bool FP8 = false>
__device__ __forceinline__ void gemm_phase(LAS unsigned char* lds, const Gemm g, const Sched& S, const Epi& E) {
    int tid_ = threadIdx.x; asm volatile("" : "+v"(tid_));
    const int tid = tid_, wid = __builtin_amdgcn_readfirstlane(tid >> 6), lane = tid & 63, wr = wid >> 2, wc = wid & 3, fr = lane & 15, fq = lane >> 4;
    const int K = g.K, nt = FP8 ? K / 128 : K / BK, lda = g.lda;
    const int pitchA = FP8 ? lda : lda * 2, pitchB = FP8 ? K : K * 2;
    unsigned voffA[2], voffB[2];
#pragma unroll
    for (int i = 0; i < 2; ++i) { int R, C; stage_rc(tid * 16 + i * 8192, R, C); const int Rb = Epi::PERM ? ((R & ~31) + perm32(R & 31)) : R;
        voffA[i] = (unsigned)(R * pitchA + C * 2); voffB[i] = (unsigned)(Rb * pitchB + C * 2); }
    const size_t kstep = (size_t)(BK * 2);
    const size_t hstepA = (size_t)HALF * pitchA, hstepB = (size_t)HALF * pitchB;
    const size_t tstepA = 2 * hstepA, tstepB = 2 * hstepB;
    const unsigned ldsw = (unsigned)wid * 1024u;
    const int aoff = lds_byte(wr * 64 + fr, fq * 8), boff = lds_byte(wc * 32 + fr, fq * 8);
#define PG8_SA(b, h) (((b) * 2 + (h)) * HTB)
#define PG8_SB(b, h) ((4 + (b) * 2 + (h)) * HTB)
#define PG8_STAGE(bufoff, gbase, voff) do { _Pragma("unroll") for (int _i = 0; _i < 2; ++_i) \
        __builtin_amdgcn_global_load_lds((const unsigned*)((const char*)(gbase) + (voff)[_i]), (LAS unsigned*)(lds + (bufoff) + ldsw + _i * 8192), 16, 0, 0); } while (0)
#define PG8_LD8(off) __builtin_shufflevector(*(const LAS i32x4*)(lds + (off)), *(const LAS i32x4*)(lds + (off) + 1024), 0, 1, 2, 3, 4, 5, 6, 7)
#define PG8_LDA(dst, b, h) do { if constexpr (FP8) { _Pragma("unroll") for (int m = 0; m < 4; ++m) dst##8[m] = PG8_LD8(PG8_SA(b, h) + aoff + m * 2048); } \
        else { _Pragma("unroll") for (int m = 0; m < 4; ++m) _Pragma("unroll") for (int k = 0; k < 2; ++k) dst[m][k] = *(const LAS bf16x8*)(lds + PG8_SA(b, h) + aoff + m * 2048 + k * 1024); } } while (0)
#define PG8_LDB(dst, b, h) do { if constexpr (FP8) { _Pragma("unroll") for (int n = 0; n < 2; ++n) dst##8[n] = PG8_LD8(PG8_SB(b, h) + boff + n * 2048); } \
        else { _Pragma("unroll") for (int n = 0; n < 2; ++n) _Pragma("unroll") for (int k = 0; k < 2; ++k) dst[n][k] = *(const LAS bf16x8*)(lds + PG8_SB(b, h) + boff + n * 2048 + k * 1024); } } while (0)
#define PG8_CAT8(x) __builtin_shufflevector(__builtin_bit_cast(i32x4, (x)[0]), __builtin_bit_cast(i32x4, (x)[1]), 0, 1, 2, 3, 4, 5, 6, 7)
#define PG8_MMA(ai, bj, At, Bt) do { __builtin_amdgcn_s_setprio(1); \
        if constexpr (FP8) { _Pragma("unroll") for (int m = 0; m < 4; ++m) _Pragma("unroll") for (int n = 0; n < 2; ++n) \
            asm volatile("v_mfma_f32_16x16x128_f8f6f4 %0, %1, %2, %0" : "+v"(acc[ai][bj][m][n]) : "v"(Bt##8[n]), "v"(At##8[m])); } \
        else { _Pragma("unroll") for (int m = 0; m < 4; ++m) _Pragma("unroll") for (int n = 0; n < 2; ++n) _Pragma("unroll") for (int k = 0; k < 2; ++k) \
            acc[ai][bj][m][n] = __builtin_amdgcn_mfma_f32_16x16x32_bf16(Bt[n][k], At[m][k], acc[ai][bj][m][n], 0, 0, 0); } \
        __builtin_amdgcn_s_setprio(0); } while (0)
#define PG8_WAIT_V(n) asm volatile("s_waitcnt vmcnt(" #n ")" ::: "memory")
#define PG8_WAIT_L(n) asm volatile("s_waitcnt lgkmcnt(" #n ")" ::: "memory")
#define PG8_BAR __builtin_amdgcn_s_barrier()
#define PG8_SCHED __builtin_amdgcn_sched_barrier(0)
    Unit cur, nxt; int ui = 0;
    if (!S.next(0, cur)) return;
    f32x4 acc[2][2][4][2];
#pragma unroll
    for (int a = 0; a < 2; ++a)
#pragma unroll
        for (int b = 0; b < 2; ++b)
#pragma unroll
            for (int m = 0; m < 4; ++m)
#pragma unroll
                for (int n = 0; n < 2; ++n) acc[a][b][m][n] = (f32x4){0.f, 0.f, 0.f, 0.f};
    bf16x8 At[4][2], B0[2][2], B1[2][2];
    i32x8 At8[4], B08[2], B18[2];
    const char* cA = (const char*)g.A + (size_t)cur.pm * tstepA; const char* cB = (const char*)g.Bt + (size_t)cur.pn * tstepB;
    PG8_STAGE(PG8_SB(0, 0), cB, voffB); PG8_STAGE(PG8_SB(0, 1), cB + hstepB, voffB); PG8_STAGE(PG8_SA(0, 0), cA, voffA); PG8_STAGE(PG8_SA(0, 1), cA + hstepA, voffA);
    if (wr == 1) PG8_BAR;
    PG8_WAIT_V(2); PG8_BAR;
    PG8_STAGE(PG8_SB(1, 0), cB + kstep, voffB); PG8_STAGE(PG8_SA(1, 0), cA + kstep, voffA); PG8_STAGE(PG8_SB(1, 1), cB + hstepB + kstep, voffB);
    PG8_WAIT_V(6); PG8_BAR;
    for (;;) {
        const bool has_next = S.next(ui + 1, nxt);
        const char* nA = has_next ? (const char*)g.A + (size_t)nxt.pm * tstepA : cA; const char* nB = has_next ? (const char*)g.Bt + (size_t)nxt.pn * tstepB : cB;
        for (int t = 0; t < nt; t += 2) {
            const bool last = (t == nt - 2);
            const char* a1 = cA + (size_t)(t + 1) * kstep;
            const char* a2 = last ? nA : cA + (size_t)(t + 2) * kstep; const char* b2 = last ? nB : cB + (size_t)(t + 2) * kstep;
            const char* a3 = a2 + kstep; const char* b3 = b2 + kstep;
            PG8_LDB(B0, 0, 0); PG8_LDB(B1, 0, 1); PG8_SCHED; PG8_LDA(At, 0, 0); PG8_STAGE(PG8_SA(1, 1), a1 + hstepA, voffA);
            PG8_WAIT_V(8); PG8_WAIT_L(0); PG8_BAR; PG8_MMA(0, 0, At, B0); PG8_MMA(0, 1, At, B1); PG8_BAR; PG8_SCHED;
            PG8_LDA(At, 0, 1); PG8_STAGE(PG8_SB(0, 0), b2, voffB); PG8_STAGE(PG8_SB(0, 1), b2 + hstepB, voffB); PG8_STAGE(PG8_SA(0, 0), a2, voffA);
            PG8_WAIT_V(8); PG8_WAIT_L(0); PG8_BAR; PG8_MMA(1, 0, At, B0); PG8_MMA(1, 1, At, B1); PG8_BAR; PG8_SCHED;
            PG8_LDB(B0, 1, 0); PG8_LDB(B1, 1, 1); PG8_SCHED; PG8_LDA(At, 1, 0); PG8_STAGE(PG8_SA(0, 1), a2 + hstepA, voffA);
            PG8_WAIT_V(8); PG8_WAIT_L(0); PG8_BAR; PG8_MMA(0, 0, At, B0); PG8_MMA(0, 1, At, B1); PG8_BAR; PG8_SCHED;
            PG8_LDA(At, 1, 1); PG8_STAGE(PG8_SB(1, 0), b3, voffB); PG8_STAGE(PG8_SB(1, 1), b3 + hstepB, voffB); PG8_STAGE(PG8_SA(1, 0), a3, voffA);
            PG8_WAIT_V(8); PG8_WAIT_L(0); PG8_BAR; PG8_MMA(1, 0, At, B0); PG8_MMA(1, 1, At, B1); PG8_BAR; PG8_SCHED;
        }
        if constexpr (ALIGN_EPI) { if (wr == 0) PG8_BAR; }
        E(acc, cur, wr, wc, fr, fq);
        if (!has_next) break;
#pragma unroll
        for (int a = 0; a < 2; ++a)
#pragma unroll
            for (int b = 0; b < 2; ++b)
#pragma unroll
                for (int m = 0; m < 4; ++m)
#pragma unroll
                    for (int n = 0; n < 2; ++n) acc[a][b][m][n] = (f32x4){0.f, 0.f, 0.f, 0.f};
        cur = nxt; cA = nA; cB = nB; ++ui;
        if constexpr (ALIGN_EPI) { if (wr == 1) PG8_BAR; }
    }
    PG8_WAIT_V(0);
    if constexpr (!ALIGN_EPI) { if (wr == 0) PG8_BAR; }
    PG8_BAR;
#undef PG8_SA
#undef PG8_SB
#undef PG8_STAGE
#undef PG8_LDA
#undef PG8_LD8
#undef PG8_LDB
#undef PG8_MMA
#undef PG8_CAT8
#undef PG8_WAIT_V
#undef PG8_WAIT_L
#undef PG8_BAR
#undef PG8_SCHED
}

typedef const f32x4 (&AccRef)[2][2][4][2];
__device__ __forceinline__ u32x4 pack8(f32x4 v0, f32x4 v1) { u32x4 w; w.x = cvt_pk_bf16(v0[0], v0[1]); w.y = cvt_pk_bf16(v0[2], v0[3]); w.z = cvt_pk_bf16(v1[0], v1[1]); w.w = cvt_pk_bf16(v1[2], v1[3]); return w; }

template <bool F8> struct EpiSwiglu {
    static constexpr bool PERM = true;
    bf16_t* O;
    __device__ __forceinline__ void operator()(AccRef acc, const Unit& u, int wr, int wc, int fr, int fq) const {
        constexpr int col_base = F8 ? FIN_BF_TILES * 128 : 0; constexpr float sc = F8 ? 1.f / G8_SCALE : 1.f;
        const int row0 = u.pm * BM + wr * 64 + fr, col0 = col_base + u.pn * HALF + wc * 32 + 8 * fq;
#pragma unroll
        for (int ai = 0; ai < 2; ++ai)
#pragma unroll
            for (int m = 0; m < 4; ++m) {
                bf16_t* p = O + (size_t)(row0 + ai * HALF + m * 16) * DFF + col0;
                const f32x4 v0 = swiglu_pk4<F8>(acc[ai][0][m][0], acc[ai][1][m][0]), v1 = swiglu_pk4<F8>(acc[ai][0][m][1], acc[ai][1][m][1]);
                *(u32x4*)p = pack8(v0, v1);
                if constexpr (F8) asm volatile("" ::: "memory");
            }
    }
};
template <bool LN> struct EpiResidT {
    static constexpr bool PERM = false;
    const float* hin; float* R; const float* gate; float gs; const float* stats; const float* lng; const float* lnb;
    __device__ __forceinline__ void operator()(AccRef acc, const Unit& u, int wr, int wc, int fr, int fq) const {
        const int row0 = u.pm * BM + wr * 64 + fr, col0 = u.pn * BM + wc * 32 + 4 * fq;
        const float* gp = gate + (size_t)(u.pm >> 4) * NMOD + col0;
        f32x2_t st[2][4];
#pragma unroll
        for (int ai = 0; ai < 2; ++ai)
#pragma unroll
            for (int m = 0; m < 4; ++m) { if constexpr (LN) st[ai][m] = *(const f32x2_t*)(stats + 2 * (size_t)(row0 + ai * HALF + m * 16)); else st[ai][m] = (f32x2_t){0.f, 1.f}; }
#pragma unroll
        for (int bj = 0; bj < 2; ++bj)
#pragma unroll
            for (int n = 0; n < 2; ++n) {
                const int co = bj * HALF + 16 * n;
                const f32x4 gv = *(const f32x4*)(gp + co) * gs;
                f32x4 lg4 = (f32x4){1.f, 1.f, 1.f, 1.f}, lb4 = (f32x4){0.f, 0.f, 0.f, 0.f};
                if constexpr (LN) { lg4 = *(const f32x4*)(lng + col0 + co); lb4 = *(const f32x4*)(lnb + col0 + co); }
                f32x4 hv[2][4];
#pragma unroll
                for (int ai = 0; ai < 2; ++ai)
#pragma unroll
                    for (int m = 0; m < 4; ++m) hv[ai][m] = *(const f32x4*)(hin + (size_t)(row0 + ai * HALF + m * 16) * DM + col0 + co);
#pragma unroll
                for (int ai = 0; ai < 2; ++ai)
#pragma unroll
                    for (int m = 0; m < 4; ++m) { const size_t off = (size_t)(row0 + ai * HALF + m * 16) * DM + col0 + co;
                        f32x4 h = hv[ai][m];
                        if constexpr (LN) h = (h - st[ai][m][0]) * st[ai][m][1] * lg4 + lb4;
                        *(f32x4*)(R + off) = h * ALPHA + gv * acc[ai][bj][m][n]; }
            }
    }
};
struct EpiMix {
    static constexpr bool PERM = true;
    bf16_t* MIX; bf16_t* GATES;
    __device__ __forceinline__ void operator()(AccRef acc, const Unit& u, int wr, int wc, int fr, int fq) const {
        const int row0 = u.pm * BM + wr * 64 + fr; int colt = u.pn * BM; bf16_t* base = MIX; int ldc = MIXP;
        if (colt >= 6144) { base = GATES; ldc = GP; colt -= 6144; }
        const int col0 = colt + wc * 32 + 8 * fq;
#pragma unroll
        for (int ai = 0; ai < 2; ++ai)
#pragma unroll
            for (int m = 0; m < 4; ++m) { bf16_t* p = base + (size_t)(row0 + ai * HALF + m * 16) * ldc + col0;
#pragma unroll
                for (int bj = 0; bj < 2; ++bj) *(u32x4*)(p + bj * HALF) = pack8(acc[ai][bj][m][0], acc[ai][bj][m][1]); }
    }
};
struct EpiGates8 {
    static constexpr bool PERM = true;
    bf16_t* GATES;
    __device__ __forceinline__ void operator()(AccRef acc, const Unit& u, int wr, int wc, int fr, int fq) const {
        const int row0 = u.pm * BM + wr * 64 + fr, col0 = u.pn * BM + wc * 32 + 8 * fq; const float sc = 1.f / G8_SCALE;
#pragma unroll
        for (int ai = 0; ai < 2; ++ai)
#pragma unroll
            for (int m = 0; m < 4; ++m) { bf16_t* p = GATES + (size_t)(row0 + ai * HALF + m * 16) * GP + col0;
#pragma unroll
                for (int bj = 0; bj < 2; ++bj) *(u32x4*)(p + bj * HALF) = pack8(acc[ai][bj][m][0] * sc, acc[ai][bj][m][1] * sc); }
    }
};
template <bool SECOND> struct EpiGate {
    static constexpr bool PERM = true;
    const bf16_t* G;
    bf16_t* T;
    bf16_t* OUT;
    __device__ __forceinline__ void operator()(AccRef acc, const Unit& u, int wr, int wc, int fr, int fq) const {
        const int row0 = u.pm * BM + wr * 64 + fr, col0 = u.pn * BM + wc * 32 + 8 * fq;
#pragma unroll
        for (int ai = 0; ai < 2; ++ai)
#pragma unroll
            for (int bj = 0; bj < 2; ++bj) {
                u32x4 gw[4], tw[4];
#pragma unroll
                for (int m = 0; m < 4; ++m) { const size_t row = (size_t)(row0 + ai * HALF + m * 16);
                    gw[m] = *(const u32x4*)(G + row * GP + col0 + bj * HALF);
                    if constexpr (SECOND) tw[m] = *(const u32x4*)(T + row * DM + col0 + bj * HALF); }
#pragma unroll
                for (int m = 0; m < 4; ++m) { const size_t row = (size_t)(row0 + ai * HALF + m * 16);
                    f32x4 v0 = gate_pk4(acc[ai][bj][m][0], gw[m].x, gw[m].y), v1 = gate_pk4(acc[ai][bj][m][1], gw[m].z, gw[m].w);
                    if constexpr (SECOND) {
                        v0[0] += bf_lo(tw[m].x); v0[1] += bf_hi(tw[m].x); v0[2] += bf_lo(tw[m].y); v0[3] += bf_hi(tw[m].y);
                        v1[0] += bf_lo(tw[m].z); v1[1] += bf_hi(tw[m].z); v1[2] += bf_lo(tw[m].w); v1[3] += bf_hi(tw[m].w);
                        *(u32x4*)(OUT + row * MIXP + col0 + bj * HALF) = pack8(v0, v1);
                    } else {
                        *(u32x4*)(T + row * DM + col0 + bj * HALF) = pack8(v0, v1);
                    }
                }
            }
    }
};
}

struct Args { const float* in[22]; float* out; unsigned char* ws; int ph_lo, ph_hi; };
enum { I_X = 0, I_C, I_WADA, I_BADA, I_F1IN, I_F1OUT, I_LN1G, I_LN1B, I_WMIX, I_RELB, I_WA2, I_BAL, I_GNG, I_WPA, I_WPB, I_WMO, I_LN2G, I_LN2B, I_F2IN, I_F2OUT, I_LN3G, I_LN3B };

struct Ctx {
    LAS unsigned char* lds; int tid, lane, wave, G, bx;
    const Args* a;
};

__device__ __forceinline__ void tr_item(const float* W, int ldw, int K, int k0, int c0, bf16_t* WT, int r0, int ncols, LAS float* scr, int lane) {
    const int cl = lane & 31;
    float tv[32];
#pragma unroll
    for (int i = 0; i < 32; ++i) { const int kk = 2 * i + (lane >> 5); tv[i] = (cl < ncols) ? W[(size_t)(k0 + kk) * ldw + c0 + cl] : 0.f; }
#pragma unroll
    for (int i = 0; i < 32; ++i) { const int kk = 2 * i + (lane >> 5); scr[kk * 33 + cl] = tv[i]; }
    asm volatile("s_waitcnt lgkmcnt(0)" ::: "memory");
    const int c = lane & 7;
#pragma unroll
    for (int j = 0; j < 4; ++j) { const int n = (lane >> 3) + 8 * j; const LAS float* s = scr + (8 * c) * 33 + n;
        u32x4 o; o.x = cvt_pk_bf16(s[0 * 33], s[1 * 33]); o.y = cvt_pk_bf16(s[2 * 33], s[3 * 33]); o.z = cvt_pk_bf16(s[4 * 33], s[5 * 33]); o.w = cvt_pk_bf16(s[6 * 33], s[7 * 33]);
        if (n < ncols) *(u32x4*)(WT + (size_t)(r0 + n) * K + k0 + 8 * c) = o; }
    asm volatile("s_waitcnt lgkmcnt(0)" ::: "memory");
}

__device__ __forceinline__ unsigned pk4_fp8(float a, float b, float c, float d) { int w = 0; w = __builtin_amdgcn_cvt_pk_fp8_f32(a, b, w, false); w = __builtin_amdgcn_cvt_pk_fp8_f32(c, d, w, true); return (unsigned)w; }
__device__ __forceinline__ void tr_item8(const float* W, int ldw, int K, int k0, int c0, unsigned char* W8, int r0, LAS float* scr, int lane) {
    const int cl = lane & 31;
    float tv[32];
#pragma unroll
    for (int i = 0; i < 32; ++i) { const int kk = 2 * i + (lane >> 5); tv[i] = W[(size_t)(k0 + kk) * ldw + c0 + cl] * G8_SCALE; }
#pragma unroll
    for (int i = 0; i < 32; ++i) { const int kk = 2 * i + (lane >> 5); scr[kk * 33 + cl] = tv[i]; }
    asm volatile("s_waitcnt lgkmcnt(0)" ::: "memory");
    const int c = lane & 3;
#pragma unroll
    for (int j = 0; j < 2; ++j) { const int n = (lane >> 2) + 16 * j; const LAS float* s = scr + (16 * c) * 33 + n;
        u32x4 o; o.x = pk4_fp8(s[0 * 33], s[1 * 33], s[2 * 33], s[3 * 33]); o.y = pk4_fp8(s[4 * 33], s[5 * 33], s[6 * 33], s[7 * 33]);
        o.z = pk4_fp8(s[8 * 33], s[9 * 33], s[10 * 33], s[11 * 33]); o.w = pk4_fp8(s[12 * 33], s[13 * 33], s[14 * 33], s[15 * 33]);
        *(u32x4*)(W8 + (size_t)(r0 + n) * K + k0 + 16 * c) = o; }
    asm volatile("s_waitcnt lgkmcnt(0)" ::: "memory");
}

__device__ __forceinline__ void p0_prologue(const Ctx& X) {
    const Args& a = *X.a; unsigned char* ws = a.ws;
    LAS float* sl = (LAS float*)X.lds;
    LAS float* red = (LAS float*)(X.lds + 32768);
    for (int i = X.tid; i < 4 * DM; i += 512) sl[i] = fast_silu(a.in[I_C][i]);
    __syncthreads();
    float* mod = (float*)(ws + WS_MOD);
    for (int it = X.bx; it < NMOD / 64; it += X.G) {
        const int j0 = it * 64; const float* wp = a.in[I_WADA] + (size_t)(256 * X.wave) * NMOD + j0 + X.lane;
        float a0 = 0.f, a1 = 0.f, a2 = 0.f, a3 = 0.f;
        for (int k8 = 0; k8 < 256; k8 += 32) { float wv[32];
#pragma unroll
            for (int q = 0; q < 32; ++q) wv[q] = wp[(size_t)(k8 + q) * NMOD];
#pragma unroll
            for (int q = 0; q < 32; ++q) { const int k = 256 * X.wave + k8 + q; a0 += sl[k] * wv[q]; a1 += sl[DM + k] * wv[q]; a2 += sl[2 * DM + k] * wv[q]; a3 += sl[3 * DM + k] * wv[q]; } }
        red[(X.wave * 4 + 0) * 64 + X.lane] = a0; red[(X.wave * 4 + 1) * 64 + X.lane] = a1; red[(X.wave * 4 + 2) * 64 + X.lane] = a2; red[(X.wave * 4 + 3) * 64 + X.lane] = a3;
        __syncthreads();
        if (X.tid < 256) { const int b = X.tid >> 6, l = X.tid & 63; float s = a.in[I_BADA][j0 + l];
#pragma unroll
            for (int w = 0; w < 8; ++w) s += red[(w * 4 + b) * 64 + l];
            mod[(size_t)b * NMOD + j0 + l] = s; }
        __syncthreads();
    }
    __syncthreads();
    LAS float* scr = (LAS float*)(X.lds + X.wave * 16384);
    const int gw = X.bx * 8 + X.wave, NGW = X.G * 8;
    constexpr int I_FIN = 32 * 352, I_FOUT = 88 * 64, I_MIX = 32 * 320, I_LR = 32, I_P = 16 * 64, I_MO = 32 * 64;
    constexpr int NITEMS = 2 * I_FIN + 2 * I_FOUT + I_MIX + I_LR + 2 * I_P + I_MO;
    for (int it = gw; it < NITEMS; it += NGW) {
        int r = it;
        if (r < 2 * I_FIN) { const int which = r >= I_FIN; r -= which * I_FIN; const int kb = r / 352, nb = r % 352, c0 = 32 * nb, bj = c0 / DFF, j = c0 % DFF;
            const int rd = 256 * (j / 128) + 128 * bj + (j % 128);
            if (rd < FIN_BF_TILES * 256) tr_item(a.in[which ? I_F2IN : I_F1IN], 2 * DFF, DM, 64 * kb, c0, (bf16_t*)(ws + (which ? WS_W2IN : WS_W1IN)), rd, 32, scr, X.lane);
            else tr_item8(a.in[which ? I_F2IN : I_F1IN], 2 * DFF, DM, 64 * kb, c0, ws + (which ? WS_W2IN8 : WS_W1IN8), rd - FIN_BF_TILES * 256, scr, X.lane);
            continue; }
        r -= 2 * I_FIN;
        if (r < 2 * I_FOUT) { const int which = r >= I_FOUT; r -= which * I_FOUT; const int kb = r / 64, nb = r % 64;
            tr_item(a.in[which ? I_F2OUT : I_F1OUT], DM, DFF, 64 * kb, 32 * nb, (bf16_t*)(ws + (which ? WS_W2OUT : WS_W1OUT)), 32 * nb, 32, scr, X.lane); continue; }
        r -= 2 * I_FOUT;
        if (r < I_MIX) { const int kb = r / 320, nb = r % 320, r0 = 32 * nb, c0 = r0 < 6144 ? r0 : r0 + 16;
            if (r0 < 6144) tr_item(a.in[I_WMIX], WMIX_SRC_LD, DM, 64 * kb, c0, (bf16_t*)(ws + WS_WMIX), r0, 32, scr, X.lane);
            else tr_item8(a.in[I_WMIX], WMIX_SRC_LD, DM, 64 * kb, c0, ws + WS_WG8, r0 - 6144, scr, X.lane);
            continue; }
        r -= I_MIX;
        if (r < I_LR) { tr_item(a.in[I_WMIX], WMIX_SRC_LD, DM, 64 * r, 6144, (bf16_t*)(ws + WS_WLR), 0, 16, scr, X.lane); continue; }
        r -= I_LR;
        if (r < 2 * I_P) { const int which = r >= I_P; r -= which * I_P; const int kb = r / 64, nb = r % 64;
            tr_item(a.in[which ? I_WPB : I_WPA], DM, 1024, 64 * kb, 32 * nb, (bf16_t*)(ws + (which ? WS_WPB : WS_WPA)), 32 * nb, 32, scr, X.lane); continue; }
        r -= 2 * I_P;
        { const int kb = r / 64, nb = r % 64; tr_item(a.in[I_WMO], DM, DM, 64 * kb, 32 * nb, (bf16_t*)(ws + WS_WMO), 32 * nb, 32, scr, X.lane); }
    }
}

__device__ __forceinline__ void p_modulate(const Ctx& X, const float* x, const float* mod, int sh_off, bf16_t* U, unsigned char* U8) {
    const size_t n8 = (size_t)M_TOK * DM / 8, stride = (size_t)X.G * 512;
    for (size_t i0 = (size_t)X.bx * 512 + X.tid; i0 < n8; i0 += 2 * stride) {
        const size_t i1 = i0 + stride; const bool two = i1 < n8;
        const int rowa = (int)(i0 >> 8), ca = (int)(i0 & 255) * 8, rowb = two ? (int)(i1 >> 8) : rowa, cb = two ? (int)(i1 & 255) * 8 : ca;
        const float* ma = mod + (size_t)(rowa >> 12) * NMOD + sh_off + ca; const float* mb = mod + (size_t)(rowb >> 12) * NMOD + sh_off + cb;
        const f32x4 xa0 = *(const f32x4*)(x + (size_t)rowa * DM + ca), xa1 = *(const f32x4*)(x + (size_t)rowa * DM + ca + 4), xb0 = *(const f32x4*)(x + (size_t)rowb * DM + cb), xb1 = *(const f32x4*)(x + (size_t)rowb * DM + cb + 4);
        const f32x4 sa0 = *(const f32x4*)(ma), sa1 = *(const f32x4*)(ma + 4), ka0 = *(const f32x4*)(ma + DM), ka1 = *(const f32x4*)(ma + DM + 4);
        const f32x4 sb0 = *(const f32x4*)(mb), sb1 = *(const f32x4*)(mb + 4), kb0 = *(const f32x4*)(mb + DM), kb1 = *(const f32x4*)(mb + DM + 4);
        { const f32x4 u0 = xa0 * (1.f + ka0) + sa0, u1 = xa1 * (1.f + ka1) + sa1;
          *(u32x4*)(U + (size_t)rowa * DM + ca) = pg8::pack8(u0, u1);
          u32x2 w8; w8.x = pk4_fp8(u0[0], u0[1], u0[2], u0[3]); w8.y = pk4_fp8(u1[0], u1[1], u1[2], u1[3]); *(u32x2*)(U8 + (size_t)rowa * DM + ca) = w8; }
        if (two) { const f32x4 u0 = xb0 * (1.f + kb0) + sb0, u1 = xb1 * (1.f + kb1) + sb1;
          *(u32x4*)(U + (size_t)rowb * DM + cb) = pg8::pack8(u0, u1);
          u32x2 w8; w8.x = pk4_fp8(u0[0], u0[1], u0[2], u0[3]); w8.y = pk4_fp8(u1[0], u1[1], u1[2], u1[3]); *(u32x2*)(U8 + (size_t)rowb * DM + cb) = w8; }
    }
}

template <bool LAST, bool F8 = false>
__device__ __forceinline__ void p_layernorm(const Ctx& X, const float* R, const float* lg, const float* lb, float* Hout, float* stats, const float* mod, int sh_off, bf16_t* U, unsigned char* U8 = nullptr) {
    const int gw = X.bx * 8 + X.wave, NGW = X.G * 8;
    f32x4 vn[8];
    if (gw < M_TOK) {
#pragma unroll
        for (int j = 0; j < 8; ++j) vn[j] = *(const f32x4*)(R + (size_t)gw * DM + 4 * X.lane + 256 * j);
    }
    for (int row = gw; row < M_TOK; row += NGW) {
        f32x4 v[8]; float s = 0.f;
#pragma unroll
        for (int j = 0; j < 8; ++j) { v[j] = vn[j]; s += (v[j][0] + v[j][1]) + (v[j][2] + v[j][3]); }
        if (row + NGW < M_TOK) {
#pragma unroll
            for (int j = 0; j < 8; ++j) vn[j] = *(const f32x4*)(R + (size_t)(row + NGW) * DM + 4 * X.lane + 256 * j);
        }
        const float mean = wave_sum(s) * (1.f / DM); float s2 = 0.f;
#pragma unroll
        for (int j = 0; j < 8; ++j) { v[j] = v[j] - mean; s2 += (v[j][0] * v[j][0] + v[j][1] * v[j][1]) + (v[j][2] * v[j][2] + v[j][3] * v[j][3]); }
        const float rstd = 1.f / sqrtf(wave_sum(s2) * (1.f / DM) + LN_EPS);
        const float* mp = LAST ? nullptr : mod + (size_t)(row >> 12) * NMOD + sh_off + 4 * X.lane;
        if constexpr (!LAST) { if (X.lane == 0) *(f32x2_t*)(stats + 2 * (size_t)row) = (f32x2_t){mean, rstd}; }
#pragma unroll
        for (int j = 0; j < 8; ++j) {
            const f32x4 g4 = *(const f32x4*)(lg + 4 * X.lane + 256 * j), b4 = *(const f32x4*)(lb + 4 * X.lane + 256 * j);
            const f32x4 y = v[j] * rstd * g4 + b4;
            if constexpr (LAST) *(f32x4*)(Hout + (size_t)row * DM + 4 * X.lane + 256 * j) = y;
            if constexpr (!LAST) { const f32x4 sh = *(const f32x4*)(mp + 256 * j), sc = *(const f32x4*)(mp + DM + 256 * j); const f32x4 uu = y * (1.f + sc) + sh;
                u32x2 w; w.x = cvt_pk_bf16(uu[0], uu[1]); w.y = cvt_pk_bf16(uu[2], uu[3]); *(u32x2*)(U + (size_t)row * DM + 4 * X.lane + 256 * j) = w;
                if constexpr (F8) *(unsigned*)(U8 + (size_t)row * DM + 4 * X.lane + 256 * j) = pk4_fp8(uu[0], uu[1], uu[2], uu[3]); }
        }
    }
}

__device__ __forceinline__ s16x4 tr_read(const LAS unsigned char* p) { return __builtin_bit_cast(s16x4, __builtin_amdgcn_ds_read_tr16_b64_v4i16((LAS s16x4*)p)); }
__device__ __forceinline__ bf16x8 cat8(s16x4 a, s16x4 b) { return (bf16x8){a[0], a[1], a[2], a[3], b[0], b[1], b[2], b[3]}; }

constexpr int KD_P = 1088, V_P = 576, OT_P = 528;
constexpr int L1_RED = 0, L1_LRS = 32768, L1_KD = 36864, L1_V = L1_KD + 64 * KD_P, L1_END = L1_V + 64 * V_P;
static_assert(L1_END <= 147456, "gla chunk LDS");

__device__ __forceinline__ void p_gla_chunk(const Ctx& X, const bf16_t* U, const bf16_t* WLR, const bf16_t* MIX, float* DEC, bf16_t* UB, const float* wa2, const float* bal) {
    LAS unsigned char* lds = X.lds;
    LAS float* red = (LAS float*)(lds + L1_RED);
    LAS float* lrs = (LAS float*)(lds + L1_LRS);
    const int tid = X.tid, lane = X.lane, w = X.wave, l15 = lane & 15, g = lane >> 4;
    const int tr_row = 8 * g + (l15 >> 2), tr_col = 4 * (l15 & 3);
    const int vr = tid >> 5, vc = tid & 31;
    for (int ch = X.bx; ch < 256; ch += X.G) {
        const size_t t0 = (size_t)ch * 64;
        f32x4 acc[4];
#pragma unroll
        for (int mi = 0; mi < 4; ++mi) acc[mi] = (f32x4){0.f, 0.f, 0.f, 0.f};
        const int kw = 256 * w + 8 * g;
#pragma unroll
        for (int s = 0; s < 8; ++s) {
            const bf16x8 bfr = *(const bf16x8*)(WLR + (size_t)l15 * DM + kw + 32 * s);
#pragma unroll
            for (int mi = 0; mi < 4; ++mi) { const bf16x8 afr = *(const bf16x8*)(U + (t0 + 16 * mi + l15) * DM + kw + 32 * s);
                acc[mi] = __builtin_amdgcn_mfma_f32_16x16x32_bf16(afr, bfr, acc[mi], 0, 0, 0); }
        }
#pragma unroll
        for (int mi = 0; mi < 4; ++mi)
#pragma unroll
            for (int e = 0; e < 4; ++e) red[(w * 64 + 16 * mi + 4 * g + e) * 16 + l15] = acc[mi][e];
        __syncthreads();
        for (int i = tid; i < 1024; i += 512) { float s = 0.f;
#pragma unroll
            for (int ww = 0; ww < 8; ++ww) s += red[ww * 1024 + i];
            lrs[i] = s; }
        __syncthreads();
        {   const int kp = tid;
            float wa[16];
#pragma unroll
            for (int r = 0; r < 16; ++r) wa[r] = wa2[r * 512 + kp];
            const float ba = bal[kp];
            float cum[64]; float run = 0.f;
#pragma unroll
            for (int c = 0; c < 64; ++c) {
                float z = ba;
#pragma unroll
                for (int r4 = 0; r4 < 4; ++r4) { const f32x4 l4 = *(const LAS f32x4*)(lrs + c * 16 + 4 * r4);
                    z += l4[0] * wa[4 * r4] + l4[1] * wa[4 * r4 + 1] + l4[2] * wa[4 * r4 + 2] + l4[3] * wa[4 * r4 + 3]; }
                const float ls = fminf(z, 0.f) - __logf(1.f + __expf(-fabsf(z)));
                run += ls * (1.f / 16.f); cum[c] = run;
            }
            DEC[(size_t)ch * 512 + kp] = __expf(run);
            const bf16_t* kptr = MIX + t0 * MIXP + C_KB + kp;
#pragma unroll
            for (int c = 0; c < 64; ++c) { const float kv = __uint_as_float((unsigned)kptr[(size_t)c * MIXP] << 16); const float kd = kv * __expf(run - cum[c]);
                *(LAS bf16_t*)(lds + L1_KD + c * KD_P + kp * 2) = (bf16_t)(cvt_pk_bf16(kd, 0.f) & 0xffffu); }
        }
        for (int h = 0; h < 4; ++h) {
            u32x4 pv[4];
#pragma unroll
            for (int i = 0; i < 4; ++i) pv[i] = *(const u32x4*)(MIX + (t0 + vr + 16 * i) * MIXP + C_VB + h * 256 + vc * 8);
            __syncthreads();
#pragma unroll
            for (int i = 0; i < 4; ++i) *(LAS u32x4*)(lds + L1_V + (vr + 16 * i) * V_P + vc * 16) = pv[i];
            __syncthreads();
            f32x4 uacc[2][8];
#pragma unroll
            for (int vt = 0; vt < 2; ++vt)
#pragma unroll
                for (int kt = 0; kt < 8; ++kt) uacc[vt][kt] = (f32x4){0.f, 0.f, 0.f, 0.f};
#pragma unroll
            for (int s = 0; s < 2; ++s) {
                bf16x8 va[2];
#pragma unroll
                for (int vt = 0; vt < 2; ++vt) { const LAS unsigned char* p = lds + L1_V + (32 * s + tr_row) * V_P + (32 * w + 16 * vt + tr_col) * 2; va[vt] = cat8(tr_read(p), tr_read(p + 4 * V_P)); }
#pragma unroll
                for (int kt = 0; kt < 8; ++kt) { const LAS unsigned char* p = lds + L1_KD + (32 * s + tr_row) * KD_P + (h * 128 + 16 * kt + tr_col) * 2;
                    const bf16x8 kf = cat8(tr_read(p), tr_read(p + 4 * KD_P));
                    uacc[0][kt] = __builtin_amdgcn_mfma_f32_16x16x32_bf16(va[0], kf, uacc[0][kt], 0, 0, 0);
                    uacc[1][kt] = __builtin_amdgcn_mfma_f32_16x16x32_bf16(va[1], kf, uacc[1][kt], 0, 0, 0); }
            }
            bf16_t* up = UB + ((size_t)(ch * 4 + h) * 128) * 256;
#pragma unroll
            for (int vt = 0; vt < 2; ++vt)
#pragma unroll
                for (int kt = 0; kt < 8; ++kt) { u32x2 o; o.x = cvt_pk_bf16(uacc[vt][kt][0], uacc[vt][kt][1]); o.y = cvt_pk_bf16(uacc[vt][kt][2], uacc[vt][kt][3]);
                    *(u32x2*)(up + (size_t)(16 * kt + l15) * 256 + 32 * w + 16 * vt + 4 * g) = o; }
        }
        __syncthreads();
    }
}

__device__ __forceinline__ void p_gla_scan_elem(const Ctx& X, const float* DEC, const bf16_t* UB, bf16_t* ST) {
    for (int idx = X.bx * 512 + X.tid; idx < 4 * 4 * 128 * 64; idx += X.G * 512) {
        const int vq = idx & 63, k = (idx >> 6) & 127, h = (idx >> 13) & 3, b = idx >> 15;
        const size_t off0 = ((size_t)((b * 64) * 4 + h) * 128 + k) * 256 + 4 * vq;
        const bf16_t* p0 = UB + off0; bf16_t* s0 = ST + off0;
        const float* d0 = DEC + (size_t)(b * 64) * 512 + h * 128 + k;
        f32x4 st = (f32x4){0.f, 0.f, 0.f, 0.f};
        for (int n8 = 0; n8 < 64; n8 += 8) {
            u32x2 uv[8]; float dv[8];
#pragma unroll
            for (int q = 0; q < 8; ++q) { uv[q] = *(const u32x2*)(p0 + (size_t)(n8 + q) * (4 * 128 * 256)); dv[q] = d0[(size_t)(n8 + q) * 512]; }
#pragma unroll
            for (int q = 0; q < 8; ++q) { const f32x4 uu = (f32x4){bf_lo(uv[q].x), bf_hi(uv[q].x), bf_lo(uv[q].y), bf_hi(uv[q].y)}; st = st * dv[q] + uu;
                u32x2 o; o.x = cvt_pk_bf16(st[0], st[1]); o.y = cvt_pk_bf16(st[2], st[3]); *(u32x2*)(s0 + (size_t)(n8 + q) * (4 * 128 * 256)) = o; }
        }
    }
}

constexpr int L3_S = 0, L3_SS = 128 * V_P, L3_OT = L3_SS + 2048, L3_END = L3_OT + 64 * OT_P;
static_assert(L3_END <= 131072, "gla readout LDS");
__device__ __forceinline__ void p_gla_readout(const Ctx& X, bf16_t* MIX, const bf16_t* UB, const float* gng) {
    LAS unsigned char* lds = X.lds;
    const int tid = X.tid, lane = X.lane, w = X.wave, l15 = lane & 15, g = lane >> 4;
    const int tr_row = 8 * g + (l15 >> 2), tr_col = 4 * (l15 & 3);
    const int vr = tid >> 5, vc = tid & 31;
    const float qscale = 0.08838834764831845f;
    for (int uid = X.bx; uid < 1024; uid += X.G) {
        const int ch = uid >> 2, h = uid & 3; const size_t t0 = (size_t)ch * 64;
        const bf16_t* sp = UB + ((size_t)(ch * 4 + h) * 128) * 256;
        u32x4 sv[8], rbv[4];
#pragma unroll
        for (int i = 0; i < 8; ++i) sv[i] = *(const u32x4*)(sp + (size_t)(vr + 16 * i) * 256 + vc * 8);
#pragma unroll
        for (int i = 0; i < 4; ++i) rbv[i] = *(const u32x4*)(MIX + (t0 + vr + 16 * i) * MIXP + C_RB + h * 256 + vc * 8);
        bf16x8 qf[4][4];
#pragma unroll
        for (int mc = 0; mc < 4; ++mc)
#pragma unroll
            for (int s = 0; s < 4; ++s) qf[mc][s] = *(const bf16x8*)(MIX + (t0 + 16 * mc + l15) * MIXP + C_QB + h * 128 + 32 * s + 8 * g);
#pragma unroll
        for (int i = 0; i < 8; ++i) *(LAS u32x4*)(lds + L3_S + (vr + 16 * i) * V_P + vc * 16) = sv[i];
        __syncthreads();
        f32x4 o[4][2];
#pragma unroll
        for (int mc = 0; mc < 4; ++mc) { o[mc][0] = (f32x4){0.f, 0.f, 0.f, 0.f}; o[mc][1] = (f32x4){0.f, 0.f, 0.f, 0.f}; }
#pragma unroll
        for (int s = 0; s < 4; ++s) {
            bf16x8 sb[2];
#pragma unroll
            for (int nt = 0; nt < 2; ++nt) { const LAS unsigned char* p = lds + L3_S + (32 * s + tr_row) * V_P + (32 * w + 16 * nt + tr_col) * 2; sb[nt] = cat8(tr_read(p), tr_read(p + 4 * V_P)); }
#pragma unroll
            for (int mc = 0; mc < 4; ++mc) { o[mc][0] = __builtin_amdgcn_mfma_f32_16x16x32_bf16(qf[mc][s], sb[0], o[mc][0], 0, 0, 0);
                o[mc][1] = __builtin_amdgcn_mfma_f32_16x16x32_bf16(qf[mc][s], sb[1], o[mc][1], 0, 0, 0); }
        }
#pragma unroll
        for (int mc = 0; mc < 4; ++mc) { f32x4 q2 = o[mc][0] * o[mc][0] + o[mc][1] * o[mc][1];
#pragma unroll
            for (int sh = 1; sh < 16; sh <<= 1) { q2[0] += __shfl_xor(q2[0], sh); q2[1] += __shfl_xor(q2[1], sh); q2[2] += __shfl_xor(q2[2], sh); q2[3] += __shfl_xor(q2[3], sh); }
            if (l15 == 0) *(LAS f32x4*)(lds + L3_SS + (w * 64 + 16 * mc + 4 * g) * 4) = q2; }
        __syncthreads();
#pragma unroll
        for (int mc = 0; mc < 4; ++mc) { f32x4 tot = (f32x4){0.f, 0.f, 0.f, 0.f};
#pragma unroll
            for (int ww = 0; ww < 8; ++ww) tot += *(const LAS f32x4*)(lds + L3_SS + (ww * 64 + 16 * mc + 4 * g) * 4);
#pragma unroll
            for (int e = 0; e < 4; ++e) { const float rs = qscale * __builtin_amdgcn_rsqf(tot[e] * (qscale * qscale / 256.f) + RMS_EPS);
#pragma unroll
                for (int nt = 0; nt < 2; ++nt) *(LAS bf16_t*)(lds + L3_OT + (16 * mc + 4 * g + e) * OT_P + (32 * w + 16 * nt + l15) * 2) = (bf16_t)(cvt_pk_bf16(o[mc][nt][e] * rs, 0.f) & 0xffffu); } }
        __syncthreads();
#pragma unroll
        for (int i = 0; i < 4; ++i) { const int row = vr + 16 * i; const u32x4 ot = *(const LAS u32x4*)(lds + L3_OT + row * OT_P + vc * 16);
            const f32x4 g0 = *(const f32x4*)(gng + vc * 8), g1 = *(const f32x4*)(gng + vc * 8 + 4); const u32x4 rb = rbv[i];
            f32x4 y0, y1;
            y0[0] = bf_lo(ot.x) * g0[0] * fast_silu(bf_lo(rb.x)); y0[1] = bf_hi(ot.x) * g0[1] * fast_silu(bf_hi(rb.x)); y0[2] = bf_lo(ot.y) * g0[2] * fast_silu(bf_lo(rb.y)); y0[3] = bf_hi(ot.y) * g0[3] * fast_silu(bf_hi(rb.y));
            y1[0] = bf_lo(ot.z) * g1[0] * fast_silu(bf_lo(rb.z)); y1[1] = bf_hi(ot.z) * g1[1] * fast_silu(bf_hi(rb.z)); y1[2] = bf_lo(ot.w) * g1[2] * fast_silu(bf_lo(rb.w)); y1[3] = bf_hi(ot.w) * g1[3] * fast_silu(bf_hi(rb.w));
            *(u32x4*)(MIX + (t0 + row) * MIXP + C_RB + h * 256 + vc * 8) = pg8::pack8(y0, y1); }
    }
}

__device__ __forceinline__ int crow(int r, int hi) { return (r & 3) + 8 * (r >> 2) + 4 * hi; }
constexpr int AV_P = 192, A_WAVE_BYTES = 64 * AV_P + 256, L_ABIAS = 8 * A_WAVE_BYTES;
static_assert(L_ABIAS + 16 * 320 * 4 <= 131072, "attention LDS");

__device__ __forceinline__ void attn_unit(const Ctx& X, bf16_t* MIX, int b, int h, int n, int half) {
    const int lane = X.lane, r32 = lane & 31, hi = lane >> 5;
    LAS unsigned char* wl = X.lds + X.wave * A_WAVE_BYTES;
    LAS float* wsf = (LAS float*)(wl + 64 * AV_P);
    const LAS float* bias2 = (const LAS float*)(X.lds + L_ABIAS) + h * 320;
    const size_t trow0 = (size_t)b * SEQ + n * 64 + half * 32;
    bf16x8 qr[4];
    { const bf16_t* Qp = MIX + (trow0 + r32) * MIXP + C_QA + h * 64 + hi * 8;
#pragma unroll
      for (int d0 = 0; d0 < 4; ++d0) qr[d0] = *(const bf16x8*)(Qp + d0 * 16); }
    f32x16 o0, o1;
#pragma unroll
    for (int r = 0; r < 16; ++r) { o0[r] = 0.f; o1[r] = 0.f; }
    float mrun = -1e30f, lrun = 0.f;
    const int vbase = (4 * hi + ((lane & 15) >> 2)) * AV_P + (16 * ((lane >> 4) & 1) + 4 * (lane & 3)) * 2;
    const float sc2 = 0.125f * LOG2E;
    const int j0 = (n >= 8 ? 0 : 8 - n);
    bf16x8 k0[4], k1[4]; u32x4 vv[8];
#define ATT_LOAD(j_) do { const size_t kv0_ = (size_t)b * SEQ + (size_t)(n - 8 + (j_)) * 64; \
        const bf16_t* Kp_ = MIX + (kv0_ + r32) * MIXP + C_KA + h * 64 + hi * 8; \
        _Pragma("unroll") for (int d0 = 0; d0 < 4; ++d0) { k0[d0] = *(const bf16x8*)(Kp_ + d0 * 16); k1[d0] = *(const bf16x8*)(Kp_ + (size_t)32 * MIXP + d0 * 16); } \
        const bf16_t* Vp_ = MIX + (kv0_ + (lane >> 3)) * MIXP + C_VA + h * 64 + (lane & 7) * 8; \
        _Pragma("unroll") for (int i = 0; i < 8; ++i) vv[i] = *(const u32x4*)(Vp_ + (size_t)(8 * i) * MIXP); } while (0)
    ATT_LOAD(j0);
    for (int j = j0; j < 9; ++j) {
#pragma unroll
        for (int i = 0; i < 8; ++i) *(LAS u32x4*)(wl + (8 * i + (lane >> 3)) * AV_P + (lane & 7) * 16) = vv[i];
        bf16x8 kc0[4], kc1[4];
#pragma unroll
        for (int d0 = 0; d0 < 4; ++d0) { kc0[d0] = k0[d0]; kc1[d0] = k1[d0]; }
        if (j + 1 < 9) ATT_LOAD(j + 1);
        f32x16 p0, p1;
#pragma unroll
        for (int r = 0; r < 16; ++r) { p0[r] = 0.f; p1[r] = 0.f; }
#pragma unroll
        for (int d0 = 0; d0 < 4; ++d0) { p0 = __builtin_amdgcn_mfma_f32_32x32x16_bf16(kc0[d0], qr[d0], p0, 0, 0, 0); p1 = __builtin_amdgcn_mfma_f32_32x32x16_bf16(kc1[d0], qr[d0], p1, 0, 0, 0); }
        if (j <= 3) { const float bc = bias2[0];
#pragma unroll
            for (int r = 0; r < 16; ++r) { p0[r] = p0[r] * sc2 + bc; p1[r] = p1[r] * sc2 + bc; }
        } else { const int rb = (j - 8) * 64 - (32 * half + r32) + 4 * hi + 256;
#pragma unroll
            for (int r = 0; r < 16; ++r) { const int c = (r & 3) + 8 * (r >> 2); const int i0 = max(rb + c, 0), i1 = max(rb + c + 32, 0);
                p0[r] = p0[r] * sc2 + bias2[i0]; p1[r] = p1[r] * sc2 + bias2[i1]; }
        }
        float mx = fmaxf(p0[0], p1[0]);
#pragma unroll
        for (int r = 1; r < 16; ++r) mx = fmaxf(mx, fmaxf(p0[r], p1[r]));
        mx = fmaxf(mx, __shfl_xor(mx, 32));
        const float mnew = fmaxf(mrun, mx), alpha = __builtin_amdgcn_exp2f(mrun - mnew); mrun = mnew;
        float rs = 0.f;
#pragma unroll
        for (int r = 0; r < 16; ++r) { p0[r] = __builtin_amdgcn_exp2f(p0[r] - mnew); p1[r] = __builtin_amdgcn_exp2f(p1[r] - mnew); rs += p0[r] + p1[r]; }
        lrun = lrun * alpha + rs;
        if (!__all(alpha == 1.0f)) {
        wsf[r32] = alpha;
#pragma unroll
        for (int g4 = 0; g4 < 4; ++g4) { const f32x4 a4 = *(const LAS f32x4*)(wsf + 8 * g4 + 4 * hi);
#pragma unroll
            for (int e = 0; e < 4; ++e) { o0[4 * g4 + e] *= a4[e]; o1[4 * g4 + e] *= a4[e]; } }
        }
        bf16x8 pa[4];
        { u32x4 t;
          t.x = cvt_pk_bf16(p0[0], p0[1]); t.y = cvt_pk_bf16(p0[2], p0[3]); t.z = cvt_pk_bf16(p0[4], p0[5]); t.w = cvt_pk_bf16(p0[6], p0[7]); pa[0] = __builtin_bit_cast(bf16x8, t);
          t.x = cvt_pk_bf16(p0[8], p0[9]); t.y = cvt_pk_bf16(p0[10], p0[11]); t.z = cvt_pk_bf16(p0[12], p0[13]); t.w = cvt_pk_bf16(p0[14], p0[15]); pa[1] = __builtin_bit_cast(bf16x8, t);
          t.x = cvt_pk_bf16(p1[0], p1[1]); t.y = cvt_pk_bf16(p1[2], p1[3]); t.z = cvt_pk_bf16(p1[4], p1[5]); t.w = cvt_pk_bf16(p1[6], p1[7]); pa[2] = __builtin_bit_cast(bf16x8, t);
          t.x = cvt_pk_bf16(p1[8], p1[9]); t.y = cvt_pk_bf16(p1[10], p1[11]); t.z = cvt_pk_bf16(p1[12], p1[13]); t.w = cvt_pk_bf16(p1[14], p1[15]); pa[3] = __builtin_bit_cast(bf16x8, t); }
#pragma unroll
        for (int kk = 0; kk < 4; ++kk) { const LAS unsigned char* p = wl + vbase + (16 * kk) * AV_P;
            const bf16x8 v0 = cat8(tr_read(p), tr_read(p + 8 * AV_P)), v1 = cat8(tr_read(p + 64), tr_read(p + 8 * AV_P + 64));
            o0 = __builtin_amdgcn_mfma_f32_32x32x16_bf16(pa[kk], v0, o0, 0, 0, 0);
            o1 = __builtin_amdgcn_mfma_f32_32x32x16_bf16(pa[kk], v1, o1, 0, 0, 0); }
    }
#undef ATT_LOAD
    lrun += __shfl_xor(lrun, 32);
    wsf[r32] = 1.f / lrun;
#pragma unroll
    for (int g4 = 0; g4 < 4; ++g4) { const f32x4 a4 = *(const LAS f32x4*)(wsf + 8 * g4 + 4 * hi);
#pragma unroll
        for (int e = 0; e < 4; ++e) { const int q = 8 * g4 + 4 * hi + e;
            *(LAS bf16_t*)(wl + q * 144 + r32 * 2) = (bf16_t)(cvt_pk_bf16(o0[4 * g4 + e] * a4[e], 0.f) & 0xffffu);
            *(LAS bf16_t*)(wl + q * 144 + 64 + r32 * 2) = (bf16_t)(cvt_pk_bf16(o1[4 * g4 + e] * a4[e], 0.f) & 0xffffu); } }
#pragma unroll
    for (int i = 0; i < 4; ++i) { const int row = 8 * i + (lane >> 3), chn = lane & 7; const u32x4 v = *(const LAS u32x4*)(wl + row * 144 + chn * 16);
        *(u32x4*)(MIX + (trow0 + row) * MIXP + C_QA + h * 64 + chn * 8) = v; }
}


#define XB_TMO      128
#define XB_XCNT(j)  (256  + 64 * (j))
#define XB_XSUB(j)  (1280 + 64 * (j))
#define XB_XGEN(j)  (2304 + 64 * (j))
#define XB_TOP      3328
#define XB_TOPGEN   3392
#define XCD_BAR_WORDS 3456
#define XB_SPIN_CAP (1u << 18)
__device__ __forceinline__ unsigned xb_ld(unsigned* p)              { return __hip_atomic_load(p, __ATOMIC_RELAXED, __HIP_MEMORY_SCOPE_AGENT); }
__device__ __forceinline__ unsigned xb_add(unsigned* p, unsigned v) { return __hip_atomic_fetch_add(p, v, __ATOMIC_RELAXED, __HIP_MEMORY_SCOPE_AGENT); }
__device__ __forceinline__ unsigned xb_xcc_id() { return (unsigned)__builtin_amdgcn_s_getreg((3 << 11) | 20) & 0xFu; }
#define XB_SPIN(cond, bar) do { unsigned _sp = 0; while (cond) { __builtin_amdgcn_s_sleep(1); \
    if ((++_sp & 255u) == 0u) { if (xb_ld(&(bar)[XB_TMO])) break; if (_sp > XB_SPIN_CAP) { atomicAdd(&(bar)[XB_TMO], 1u); break; } } } } while (0)
struct XcdBarrier { unsigned* bar; unsigned x; volatile LAS unsigned* st; };
__device__ __forceinline__ XcdBarrier xcd_barrier_post(unsigned* bar, volatile LAS unsigned* st) {
    XcdBarrier b; b.bar = bar; b.x = xb_xcc_id(); b.st = st;
    if (threadIdx.x == 0) (void)xb_add(&bar[XB_XCNT(b.x)], 1u);
    return b;
}
__device__ __forceinline__ void xcd_barrier_complete(unsigned* bar, unsigned x, unsigned& nloc, unsigned& nx) {
    const unsigned G = gridDim.x * gridDim.y * gridDim.z;
    unsigned sum, cnt, mine, sp = 0u;
    for (;;) {
        sum = 0u; cnt = 0u; mine = 0u;
#pragma unroll
        for (unsigned j = 0; j < 16; ++j) { const unsigned c = xb_ld(&bar[XB_XCNT(j)]); sum += c; cnt += (c > 0u) ? 1u : 0u; mine = (j == x) ? c : mine; }
        if (sum == G) break;
        __builtin_amdgcn_s_sleep(1);
        if ((++sp & 255u) == 0u) { if (xb_ld(&bar[XB_TMO])) break; if (sp > XB_SPIN_CAP) { atomicAdd(&bar[XB_TMO], 1u); break; } }
    }
    nloc = mine > 0u ? mine : 1u; nx = cnt > 0u ? cnt : 1u;
}
__device__ __forceinline__ void xcd_barrier(const XcdBarrier& b) {
    asm volatile("s_waitcnt vmcnt(0)" ::: "memory");
    __syncthreads();
    if (threadIdx.x == 0) {
        unsigned* bar = b.bar;
        __builtin_amdgcn_s_waitcnt(0);
        unsigned nloc = b.st[0], nx = b.st[1];
        if (nloc == 0u) { xcd_barrier_complete(bar, b.x, nloc, nx); b.st[0] = nloc; b.st[1] = nx; }
        const unsigned old = xb_add(&bar[XB_XSUB(b.x)], 1u);
        const unsigned gen = old / nloc;
        if (old + 1u == (gen + 1u) * nloc) {
            __builtin_amdgcn_fence(__ATOMIC_RELEASE, "agent");
            asm volatile("s_waitcnt vmcnt(0)" ::: "memory");
            const unsigned og = xb_add(&bar[XB_TOP], 1u);
            const unsigned tg = og / nx;
            if (og + 1u == (tg + 1u) * nx) xb_add(&bar[XB_TOPGEN], 1u);
            else XB_SPIN(xb_ld(&bar[XB_TOPGEN]) == tg, bar);
            __builtin_amdgcn_fence(__ATOMIC_ACQUIRE, "agent");
            xb_add(&bar[XB_XGEN(b.x)], 1u);
            asm volatile("s_waitcnt vmcnt(0)" ::: "memory");
        } else {
            XB_SPIN(xb_ld(&bar[XB_XGEN(b.x)]) == gen, bar);
            __builtin_amdgcn_fence(__ATOMIC_ACQUIRE, "agent");
            asm volatile("s_waitcnt vmcnt(0)" ::: "memory");
        }
    }
    __syncthreads();
}

__global__ void __launch_bounds__(512, 2) fwd_megakernel(Args args) {
    extern __shared__ __attribute__((aligned(16))) unsigned char lds_raw[];
    Ctx X; X.lds = (LAS unsigned char*)lds_raw; X.tid = threadIdx.x; X.lane = X.tid & 63; X.wave = __builtin_amdgcn_readfirstlane(X.tid >> 6); X.G = gridDim.x; X.bx = blockIdx.x; X.a = &args;
    unsigned char* ws = args.ws;
    float* mod = (float*)(ws + WS_MOD); float* DEC = (float*)(ws + WS_DEC);
    bf16_t* W1IN = (bf16_t*)(ws + WS_W1IN); bf16_t* W1OUT = (bf16_t*)(ws + WS_W1OUT); bf16_t* WMIX = (bf16_t*)(ws + WS_WMIX); bf16_t* WLR = (bf16_t*)(ws + WS_WLR);
    bf16_t* WPA = (bf16_t*)(ws + WS_WPA); bf16_t* WPB = (bf16_t*)(ws + WS_WPB); bf16_t* WMO = (bf16_t*)(ws + WS_WMO); bf16_t* W2IN = (bf16_t*)(ws + WS_W2IN); bf16_t* W2OUT = (bf16_t*)(ws + WS_W2OUT);
    bf16_t* U = (bf16_t*)(ws + WS_U); float* H = (float*)(ws + WS_H); bf16_t* ACT = (bf16_t*)(ws + WS_BIG); bf16_t* MIX = (bf16_t*)(ws + WS_BIG); bf16_t* UB = (bf16_t*)(ws + WS_UB); unsigned char* U8 = ws + WS_UB;     bf16_t* ST = (bf16_t*)(ws + WS_W1IN);
    float* R = args.out; bf16_t* GATES = (bf16_t*)(ws + WS_H); float* STATS = (float*)(ws + WS_STAT);
    const int lo = args.ph_lo, hi = args.ph_hi;
    cg::grid_group grid = cg::this_grid();
    volatile LAS unsigned* MISC = (volatile LAS unsigned*)(X.lds + LDS_MISC);
    if (X.tid < 16) MISC[X.tid] = 0u;
    __syncthreads();
    XcdBarrier bar; bar.bar = (unsigned*)(ws + WS_BAR); bar.x = 0; bar.st = nullptr;
    if (hi - lo > 1) { bar = xcd_barrier_post((unsigned*)(ws + WS_BAR), MISC); grid.sync(); }
#define NREP(k) (1 + ((PROBE_DUP >> (k)) & 1))
#define PHASE(k, ...) if (lo <= (k) && (k) < hi) { __VA_ARGS__ if (NREP(k) == 2) { xcd_barrier(bar); __VA_ARGS__ } }
#define SEAM(k) do { if (lo <= (k) && (k) + 1 < hi) xcd_barrier(bar); } while (0)

    PHASE(0, { p0_prologue(X); }) SEAM(0);
    PHASE(1, { p_modulate(X, args.in[I_X], mod, 0, U, U8); }) SEAM(1);
    PHASE(2, { { pg8::Gemm g{U, W1IN, M_TOK, FIN_BF_TILES * 256, DM, DM}; pg8::StaticOrder S; S.init(M_TOK, FIN_BF_TILES * 256, X.G, X.bx); pg8::EpiSwiglu<false> E{ACT};
          pg8::gemm_phase<pg8::EpiSwiglu<false>, pg8::StaticOrder, true>(X.lds, g, S, E); }
        { pg8::Gemm g{(const bf16_t*)U8, (const bf16_t*)(ws + WS_W1IN8), M_TOK, (44 - FIN_BF_TILES) * 256, DM, DM}; pg8::StaticOrder S; S.init(M_TOK, (44 - FIN_BF_TILES) * 256, X.G, X.bx); pg8::EpiSwiglu<true> E{ACT};
          pg8::gemm_phase<pg8::EpiSwiglu<true>, pg8::StaticOrder, true, true>(X.lds, g, S, E); } }) SEAM(2);
    PHASE(3, { pg8::Gemm g{ACT, W1OUT, M_TOK, DM, DFF, DFF}; pg8::StaticOrder S; S.init(M_TOK, DM, X.G, X.bx); pg8::EpiResidT<false> E{args.in[I_X], R, mod + 2 * DM, 0.5f, nullptr, nullptr, nullptr};
        pg8::gemm_phase<pg8::EpiResidT<false>, pg8::StaticOrder, ALIGN2>(X.lds, g, S, E); }) SEAM(3);
    PHASE(4, { p_layernorm<false, true>(X, R, args.in[I_LN1G], args.in[I_LN1B], nullptr, STATS, mod, 3 * DM, U, U8); }) SEAM(4);
    PHASE(5, { { pg8::Gemm g{U, WMIX, M_TOK, 6144, DM, DM}; pg8::StaticOrder S; S.init(M_TOK, 6144, X.G, X.bx); pg8::EpiMix E{MIX, GATES};
          pg8::gemm_phase<pg8::EpiMix, pg8::StaticOrder, true>(X.lds, g, S, E); }
        { pg8::Gemm g{(const bf16_t*)U8, (const bf16_t*)(ws + WS_WG8), M_TOK, 4096, DM, DM}; pg8::StaticOrder S; S.init(M_TOK, 4096, X.G, X.bx); pg8::EpiGates8 E{GATES};
          pg8::gemm_phase<pg8::EpiGates8, pg8::StaticOrder, true, true>(X.lds, g, S, E); } }) SEAM(5);
    PHASE(6, {
        p_gla_chunk(X, U, WLR, MIX, DEC, UB, args.in[I_WA2], args.in[I_BAL]);
        LAS float* bt = (LAS float*)(X.lds + L_ABIAS);
        for (int i = X.tid; i < 16 * 320; i += 512) bt[i] = args.in[I_RELB][i] * LOG2E;
        __syncthreads();
        for (int uid = X.bx * 8 + X.wave; uid < 8192; uid += X.G * 8) { const int half = uid & 1, n = (uid >> 1) & 63, bh = uid >> 7; attn_unit(X, MIX, bh >> 4, bh & 15, n, half); }
    }) SEAM(6);
    PHASE(7, { p_gla_scan_elem(X, DEC, UB, ST); }) SEAM(7);
    PHASE(8, { p_gla_readout(X, MIX, ST, args.in[I_GNG]); }) SEAM(8);
    PHASE(9, { pg8::Gemm g{MIX + C_QA, WPA, M_TOK, DM, 1024, MIXP}; pg8::StaticOrder S; S.init(M_TOK, DM, X.G, X.bx); pg8::EpiGate<false> E{GATES, U, nullptr};
        pg8::gemm_phase<pg8::EpiGate<false>, pg8::StaticOrder, true>(X.lds, g, S, E); asm volatile("s_waitcnt vmcnt(0)" ::: "memory"); __syncthreads(); })
    PHASE(10, { pg8::Gemm g{MIX + C_RB, WPB, M_TOK, DM, 1024, MIXP}; pg8::StaticOrder S; S.init(M_TOK, DM, X.G, X.bx); pg8::EpiGate<true> E{GATES + 2048, U, MIX + C_MERGED};
        pg8::gemm_phase<pg8::EpiGate<true>, pg8::StaticOrder, true>(X.lds, g, S, E); }) SEAM(10);
    PHASE(11, { pg8::Gemm g{MIX + C_MERGED, WMO, M_TOK, DM, DM, MIXP}; pg8::StaticOrder S; S.init(M_TOK, DM, X.G, X.bx); pg8::EpiResidT<true> E{R, R, mod + 5 * DM, 1.0f, STATS, args.in[I_LN1G], args.in[I_LN1B]};
        pg8::gemm_phase<pg8::EpiResidT<true>, pg8::StaticOrder, ALIGN2>(X.lds, g, S, E); }) SEAM(11);
    PHASE(12, { p_layernorm<false, true>(X, R, args.in[I_LN2G], args.in[I_LN2B], nullptr, STATS, mod, 6 * DM, U, U8); }) SEAM(12);
    PHASE(13, { { pg8::Gemm g{U, W2IN, M_TOK, FIN_BF_TILES * 256, DM, DM}; pg8::StaticOrder S; S.init(M_TOK, FIN_BF_TILES * 256, X.G, X.bx); pg8::EpiSwiglu<false> E{ACT};
          pg8::gemm_phase<pg8::EpiSwiglu<false>, pg8::StaticOrder, true>(X.lds, g, S, E); }
        { pg8::Gemm g{(const bf16_t*)U8, (const bf16_t*)(ws + WS_W2IN8), M_TOK, (44 - FIN_BF_TILES) * 256, DM, DM}; pg8::StaticOrder S; S.init(M_TOK, (44 - FIN_BF_TILES) * 256, X.G, X.bx); pg8::EpiSwiglu<true> E{ACT};
          pg8::gemm_phase<pg8::EpiSwiglu<true>, pg8::StaticOrder, true, true>(X.lds, g, S, E); } }) SEAM(13);
    PHASE(14, { pg8::Gemm g{ACT, W2OUT, M_TOK, DM, DFF, DFF}; pg8::StaticOrder S; S.init(M_TOK, DM, X.G, X.bx); pg8::EpiResidT<true> E{R, R, mod + 8 * DM, 0.5f, STATS, args.in[I_LN2G], args.in[I_LN2B]};
        pg8::gemm_phase<pg8::EpiResidT<true>, pg8::StaticOrder, ALIGN2>(X.lds, g, S, E); }) SEAM(14);
    PHASE(15, { p_layernorm<true>(X, R, args.in[I_LN3G], args.in[I_LN3B], R, nullptr, nullptr, 0, nullptr); })
#undef PHASE
#undef SEAM
}

constexpr int N_PHASES = 16;

extern "C" void kernel_launch(void* const* d_in, const int* in_sizes, int n_in, void* d_out, int out_size, void* d_ws, size_t ws_size, hipStream_t stream) {
    static int grid = 0;
    if (grid == 0) {
        if (n_in != 22 || out_size != M_TOK * DM || ws_size < WS_END) { fprintf(stderr, "kernel_launch: unexpected shapes (n_in %d, out %d, ws %zu < %zu)\n", n_in, out_size, ws_size, (size_t)WS_END); grid = -1; return; }
        int dev = 0, cus = 0, per_cu = 0;
        (void)hipGetDevice(&dev); (void)hipDeviceGetAttribute(&cus, hipDeviceAttributeMultiprocessorCount, dev);
        if (hipFuncSetAttribute((const void*)fwd_megakernel, hipFuncAttributeMaxDynamicSharedMemorySize, LDS_BYTES) != hipSuccess) { fprintf(stderr, "kernel_launch: hipFuncSetAttribute failed\n"); grid = -1; return; }
        if (hipOccupancyMaxActiveBlocksPerMultiprocessor(&per_cu, (const void*)fwd_megakernel, 512, LDS_BYTES) != hipSuccess || per_cu < 1) { fprintf(stderr, "kernel_launch: occupancy query says %d\n", per_cu); per_cu = 1; }
        (void)hipGetLastError();
        grid = cus > 0 ? cus : 256;
    }
    if (grid < 0) return;
    if (hipMemsetAsync((char*)d_ws + WS_BAR, 0, BAR_BYTES, stream) != hipSuccess) { fprintf(stderr, "kernel_launch: memset of the barrier words failed\n"); return; }
    Args a{};
    for (int i = 0; i < 22; ++i) a.in[i] = (const float*)d_in[i];
    a.out = (float*)d_out; a.ws = (unsigned char*)d_ws;
#if MK_COOP
    a.ph_lo = 0; a.ph_hi = N_PHASES;
    void* kargs[] = {&a};
    hipError_t e = hipLaunchCooperativeKernel((const void*)fwd_megakernel, dim3(grid), dim3(512), kargs, LDS_BYTES, stream);
    if (e != hipSuccess) fprintf(stderr, "kernel_launch: cooperative launch failed: %s (grid %d)\n", hipGetErrorString(e), grid);
#else
    for (int ph = 0; ph < N_PHASES; ++ph) { a.ph_lo = ph; a.ph_hi = ph + 1; hipLaunchKernelGGL(fwd_megakernel, dim3(grid), dim3(512), LDS_BYTES, stream, a); }
#endif
}
```

```cpp
#include <hip/hip_runtime.h>
#include <hip/hip_cooperative_groups.h>
#include <cstdio>
#include <cstdint>
namespace cg = cooperative_groups;

#ifndef MK_COOP
#define MK_COOP 1
#endif

#ifndef ALIGN2
#define ALIGN2 false
#endif
#ifndef PROBE_DUP
#define PROBE_DUP 0
#endif

#define LAS __attribute__((address_space(3)))
typedef unsigned short bf16_t;
typedef short bf16x8 __attribute__((ext_vector_type(8)));
typedef float f32x4 __attribute__((ext_vector_type(4)));
typedef float f32x16 __attribute__((ext_vector_type(16)));
typedef unsigned u32x4 __attribute__((ext_vector_type(4)));
typedef unsigned u32x2 __attribute__((ext_vector_type(2)));
typedef short s16x4 __attribute__((ext_vector_type(4)));
typedef int i32x4 __attribute__((ext_vector_type(4)));
typedef int i32x8 __attribute__((ext_vector_type(8)));
constexpr int FIN_BF_TILES = 36;
constexpr float G8_SCALE = 64.f;

constexpr int M_TOK = 16384, DM = 2048, DFF = 5632, SEQ = 4096, NMOD = 18432;
constexpr int MIXP = 6144;
constexpr int GP = 4096;
constexpr int C_QA = 0, C_KA = 1024, C_VA = 2048, C_QB = 3072, C_KB = 3584, C_VB = 4096, C_RB = 5120, C_MERGED = 1024;
constexpr int WMIX_SRC_LD = 10256;
constexpr float ALPHA = 1.189207115002721f;
constexpr float LN_EPS = 1e-5f, RMS_EPS = 1e-6f;
constexpr float LOG2E = 1.4426950408889634f;

constexpr size_t MiB = 1u << 20;
constexpr size_t WS_BAR = 320 * 1024, BAR_BYTES = 16384;
constexpr size_t WS_STAT = 336 * 1024;
constexpr size_t WS_MOD = 4096;
constexpr size_t WS_DEC = 512 * 1024;
constexpr size_t WS_W1IN = 1 * MiB, WS_W1OUT = 45 * MiB, WS_WMIX = 67 * MiB, WS_WLR = 107 * MiB, WS_WPA = 108 * MiB, WS_WPB = 112 * MiB,
                 WS_WMO = 116 * MiB, WS_W2IN = 124 * MiB, WS_W2OUT = 168 * MiB, WS_U = 190 * MiB, WS_H = 254 * MiB, WS_BIG = 382 * MiB, WS_UB = 574 * MiB, WS_W1IN8 = 638 * MiB, WS_W2IN8 = 642 * MiB, WS_END = 646 * MiB;

constexpr size_t WS_WG8 = 91 * MiB;
constexpr int LDS_MISC = 147456 - 64;
constexpr int LDS_BYTES = 147456;

typedef float f32x2_t __attribute__((ext_vector_type(2))); typedef __bf16 bf16x2_t __attribute__((ext_vector_type(2)));
__device__ __forceinline__ unsigned cvt_pk_bf16(float lo, float hi) { const f32x2_t v = {lo, hi}; const bf16x2_t b = __builtin_convertvector(v, bf16x2_t); return __builtin_bit_cast(unsigned, b); }
__device__ __forceinline__ float bf_lo(unsigned w) { return __uint_as_float(w << 16); }
__device__ __forceinline__ float bf_hi(unsigned w) { return __uint_as_float(w & 0xffff0000u); }
__device__ __forceinline__ float fast_sigmoid(float x) { return __builtin_amdgcn_rcpf(1.f + __builtin_amdgcn_exp2f(-LOG2E * x)); }
__device__ __forceinline__ float fast_silu(float x) { return x * fast_sigmoid(x); }
__device__ __forceinline__ f32x2_t sigmoid_pk(f32x2_t x) { const f32x2_t t = x * (-LOG2E); f32x2_t e; e[0] = __builtin_amdgcn_exp2f(t[0]); e[1] = __builtin_amdgcn_exp2f(t[1]);
    const f32x2_t d = e + 1.0f; f32x2_t r; r[0] = __builtin_amdgcn_rcpf(d[0]); r[1] = __builtin_amdgcn_rcpf(d[1]); return r; }
template <bool F8> __device__ __forceinline__ f32x2_t sigmoid_sc_pk(f32x2_t x) { constexpr float k = F8 ? -LOG2E / 64.f : -LOG2E; const f32x2_t t = x * k; f32x2_t e; e[0] = __builtin_amdgcn_exp2f(t[0]); e[1] = __builtin_amdgcn_exp2f(t[1]);
    const f32x2_t d = e + 1.0f; f32x2_t r; r[0] = __builtin_amdgcn_rcpf(d[0]); r[1] = __builtin_amdgcn_rcpf(d[1]); return r; }
template <bool F8> __device__ __forceinline__ f32x4 swiglu_pk4(f32x4 a, f32x4 b) { const f32x2_t a0 = {a[0], a[1]}, a1 = {a[2], a[3]}, b0 = {b[0], b[1]}, b1 = {b[2], b[3]};
    constexpr float s2 = F8 ? 1.f / (64.f * 64.f) : 1.f;
    f32x2_t o0 = (a0 * b0) * sigmoid_sc_pk<F8>(a0), o1 = (a1 * b1) * sigmoid_sc_pk<F8>(a1); if constexpr (F8) { o0 = o0 * s2; o1 = o1 * s2; } return (f32x4){o0[0], o0[1], o1[0], o1[1]}; }
__device__ __forceinline__ f32x4 gate_pk4(f32x4 v, unsigned glo, unsigned ghi) {
    const f32x2_t g0 = {__uint_as_float(glo << 16), __uint_as_float(glo & 0xffff0000u)}, g1 = {__uint_as_float(ghi << 16), __uint_as_float(ghi & 0xffff0000u)};
    const f32x2_t v0 = {v[0], v[1]}, v1 = {v[2], v[3]}; const f32x2_t o0 = v0 * sigmoid_pk(g0), o1 = v1 * sigmoid_pk(g1); return (f32x4){o0[0], o0[1], o1[0], o1[1]}; }
__device__ __forceinline__ float wave_sum(float v) {
#pragma unroll
    for (int o = 1; o < 64; o <<= 1) v += __shfl_xor(v, o);
    return v;
}

namespace pg8 {
constexpr int BM = 256, BK = 64, HALF = 128, HTB = HALF * BK * 2, STAGE_BYTES = 8 * HTB, NXCD = 8, WGM = 8;
__host__ __device__ __forceinline__ int lds_byte(int r, int c) { const int st = (r >> 4) * 2 + (c >> 5), rr = r & 15, cc = c & 31, ob = rr * 64 + cc * 2; return st * 1024 + (ob ^ (((ob >> 9) & 1) << 5)); }
__host__ __device__ __forceinline__ void stage_rc(int b, int& R, int& C) { const int st = b / 1024, sb = b % 1024, swz = sb ^ (((sb >> 9) & 1) << 5); R = (st >> 1) * 16 + swz / 64; C = (st & 1) * 32 + (swz % 64) / 2; }
__host__ __device__ __forceinline__ int perm32(int rho) { const int n = rho >> 4, i = rho & 15; return 8 * (i >> 2) + 4 * n + (i & 3); }

struct Unit { int pm, pn; };
struct Gemm { const bf16_t* A; const bf16_t* Bt; int M, N, K, lda; };

struct StaticOrder {
    int nM, nN, nwg, G, c;
    __host__ __device__ void init(int M, int N, int G_, int c_) { nM = M / BM; nN = N / BM; nwg = nM * nN; G = G_; c = c_; }
    __host__ __device__ bool next(int i, Unit& u) const {
        const long L = (long)i * G + c; if (L >= nwg) return false;
        int wgid = (int)L; { const int q = nwg / NXCD, r = nwg % NXCD, xcd = wgid % NXCD, off = wgid / NXCD; wgid = (xcd < r ? xcd * (q + 1) : r * (q + 1) + (xcd - r) * q) + off; }
        const int nig = WGM * nN, gid = wgid / nig, fm = gid * WGM, gsz = (nM - fm) < WGM ? (nM - fm) : WGM;
        u.pm = fm + ((wgid % nig) % gsz); u.pn = (wgid % nig) / gsz; return true;
    }
};

template <class Epi, class Sched, bool ALIGN_EPI, bool FP8 = false>
__device__ __forceinline__ void gemm_phase(LAS unsigned char* lds, const Gemm g, const Sched& S, const Epi& E) {
    int tid_ = threadIdx.x; asm volatile("" : "+v"(tid_));
    const int tid = tid_, wid = __builtin_amdgcn_readfirstlane(tid >> 6), lane = tid & 63, wr = wid >> 2, wc = wid & 3, fr = lane & 15, fq = lane >> 4;
    const int K = g.K, nt = FP8 ? K / 128 : K / BK, lda = g.lda;
    const int pitchA = FP8 ? lda : lda * 2, pitchB = FP8 ? K : K * 2;
    unsigned voffA[2], voffB[2];
#pragma unroll
    for (int i = 0; i < 2; ++i) { int R, C; stage_rc(tid * 16 + i * 8192, R, C); const int Rb = Epi::PERM ? ((R & ~31) + perm32(R & 31)) : R;
        voffA[i] = (unsigned)(R * pitchA + C * 2); voffB[i] = (unsigned)(Rb * pitchB + C * 2); }
    const size_t kstep = (size_t)(BK * 2);
    const size_t hstepA = (size_t)HALF * pitchA, hstepB = (size_t)HALF * pitchB;
    const size_t tstepA = 2 * hstepA, tstepB = 2 * hstepB;
    const unsigned ldsw = (unsigned)wid * 1024u;
    const int aoff = lds_byte(wr * 64 + fr, fq * 8), boff = lds_byte(wc * 32 + fr, fq * 8);
#define PG8_SA(b, h) (((b) * 2 + (h)) * HTB)
#define PG8_SB(b, h) ((4 + (b) * 2 + (h)) * HTB)
#define PG8_STAGE(bufoff, gbase, voff) do { _Pragma("unroll") for (int _i = 0; _i < 2; ++_i) \
        __builtin_amdgcn_global_load_lds((const unsigned*)((const char*)(gbase) + (voff)[_i]), (LAS unsigned*)(lds + (bufoff) + ldsw + _i * 8192), 16, 0, 0); } while (0)
#define PG8_LD8(off) __builtin_shufflevector(*(const LAS i32x4*)(lds + (off)), *(const LAS i32x4*)(lds + (off) + 1024), 0, 1, 2, 3, 4, 5, 6, 7)
#define PG8_LDA(dst, b, h) do { if constexpr (FP8) { _Pragma("unroll") for (int m = 0; m < 4; ++m) dst##8[m] = PG8_LD8(PG8_SA(b, h) + aoff + m * 2048); } \
        else { _Pragma("unroll") for (int m = 0; m < 4; ++m) _Pragma("unroll") for (int k = 0; k < 2; ++k) dst[m][k] = *(const LAS bf16x8*)(lds + PG8_SA(b, h) + aoff + m * 2048 + k * 1024); } } while (0)
#define PG8_LDB(dst, b, h) do { if constexpr (FP8) { _Pragma("unroll") for (int n = 0; n < 2; ++n) dst##8[n] = PG8_LD8(PG8_SB(b, h) + boff + n * 2048); } \
        else { _Pragma("unroll") for (int n = 0; n < 2; ++n) _Pragma("unroll") for (int k = 0; k < 2; ++k) dst[n][k] = *(const LAS bf16x8*)(lds + PG8_SB(b, h) + boff + n * 2048 + k * 1024); } } while (0)
#define PG8_CAT8(x) __builtin_shufflevector(__builtin_bit_cast(i32x4, (x)[0]), __builtin_bit_cast(i32x4, (x)[1]), 0, 1, 2, 3, 4, 5, 6, 7)
#define PG8_MMA(ai, bj, At, Bt) do { __builtin_amdgcn_s_setprio(1); \
        if constexpr (FP8) { _Pragma("unroll") for (int m = 0; m < 4; ++m) _Pragma("unroll") for (int n = 0; n < 2; ++n) \
            asm volatile("v_mfma_f32_16x16x128_f8f6f4 %0, %1, %2, %0" : "+v"(acc[ai][bj][m][n]) : "v"(Bt##8[n]), "v"(At##8[m])); } \
        else { _Pragma("unroll") for (int m = 0; m < 4; ++m) _Pragma("unroll") for (int n = 0; n < 2; ++n) _Pragma("unroll") for (int k = 0; k < 2; ++k) \
            acc[ai][bj][m][n] = __builtin_amdgcn_mfma_f32_16x16x32_bf16(Bt[n][k], At[m][k], acc[ai][bj][m][n], 0, 0, 0); } \
        __builtin_amdgcn_s_setprio(0); } while (0)
#define PG8_WAIT_V(n) asm volatile("s_waitcnt vmcnt(" #n ")" ::: "memory")
#define PG8_WAIT_L(n) asm volatile("s_waitcnt lgkmcnt(" #n ")" ::: "memory")
#define PG8_BAR __builtin_amdgcn_s_barrier()
#define PG8_SCHED __builtin_amdgcn_sched_barrier(0)
    Unit cur, nxt; int ui = 0;
    if (!S.next(0, cur)) return;
    f32x4 acc[2][2][4][2];
#pragma unroll
    for (int a = 0; a < 2; ++a)
#pragma unroll
        for (int b = 0; b < 2; ++b)
#pragma unroll
            for (int m = 0; m < 4; ++m)
#pragma unroll
                for (int n = 0; n < 2; ++n) acc[a][b][m][n] = (f32x4){0.f, 0.f, 0.f, 0.f};
    bf16x8 At[4][2], B0[2][2], B1[2][2];
    i32x8 At8[4], B08[2], B18[2];
    const char* cA = (const char*)g.A + (size_t)cur.pm * tstepA; const char* cB = (const char*)g.Bt + (size_t)cur.pn * tstepB;
    PG8_STAGE(PG8_SB(0, 0), cB, voffB); PG8_STAGE(PG8_SB(0, 1), cB + hstepB, voffB); PG8_STAGE(PG8_SA(0, 0), cA, voffA); PG8_STAGE(PG8_SA(0, 1), cA + hstepA, voffA);
    if (wr == 1) PG8_BAR;
    PG8_WAIT_V(2); PG8_BAR;
    PG8_STAGE(PG8_SB(1, 0), cB + kstep, voffB); PG8_STAGE(PG8_SA(1, 0), cA + kstep, voffA); PG8_STAGE(PG8_SB(1, 1), cB + hstepB + kstep, voffB);
    PG8_WAIT_V(6); PG8_BAR;
    for (;;) {
        const bool has_next = S.next(ui + 1, nxt);
        const char* nA = has_next ? (const char*)g.A + (size_t)nxt.pm * tstepA : cA; const char* nB = has_next ? (const char*)g.Bt + (size_t)nxt.pn * tstepB : cB;
        for (int t = 0; t < nt; t += 2) {
            const bool last = (t == nt - 2);
            const char* a1 = cA + (size_t)(t + 1) * kstep;
            const char* a2 = last ? nA : cA + (size_t)(t + 2) * kstep; const char* b2 = last ? nB : cB + (size_t)(t + 2) * kstep;
            const char* a3 = a2 + kstep; const char* b3 = b2 + kstep;
            PG8_LDB(B0, 0, 0); PG8_LDB(B1, 0, 1); PG8_SCHED; PG8_LDA(At, 0, 0); PG8_STAGE(PG8_SA(1, 1), a1 + hstepA, voffA);
            PG8_WAIT_V(8); PG8_WAIT_L(0); PG8_BAR; PG8_MMA(0, 0, At, B0); PG8_MMA(0, 1, At, B1); PG8_BAR; PG8_SCHED;
            PG8_LDA(At, 0, 1); PG8_STAGE(PG8_SB(0, 0), b2, voffB); PG8_STAGE(PG8_SB(0, 1), b2 + hstepB, voffB); PG8_STAGE(PG8_SA(0, 0), a2, voffA);
            PG8_WAIT_V(8); PG8_WAIT_L(0); PG8_BAR; PG8_MMA(1, 0, At, B0); PG8_MMA(1, 1, At, B1); PG8_BAR; PG8_SCHED;
            PG8_LDB(B0, 1, 0); PG8_LDB(B1, 1, 1); PG8_SCHED; PG8_LDA(At, 1, 0); PG8_STAGE(PG8_SA(0, 1), a2 + hstepA, voffA);
            PG8_WAIT_V(8); PG8_WAIT_L(0); PG8_BAR; PG8_MMA(0, 0, At, B0); PG8_MMA(0, 1, At, B1); PG8_BAR; PG8_SCHED;
            PG8_LDA(At, 1, 1); PG8_STAGE(PG8_SB(1, 0), b3, voffB); PG8_STAGE(PG8_SB(1, 1), b3 + hstepB, voffB); PG8_STAGE(PG8_SA(1, 0), a3, voffA);
            PG8_WAIT_V(8); PG8_WAIT_L(0); PG8_BAR; PG8_MMA(1, 0, At, B0); PG8_MMA(1, 1, At, B1); PG8_BAR; PG8_SCHED;
        }
        if constexpr (ALIGN_EPI) { if (wr == 0) PG8_BAR; }
        E(acc, cur, wr, wc, fr, fq);
        if (!has_next) break;
#pragma unroll
        for (int a = 0; a < 2; ++a)
#pragma unroll
            for (int b = 0; b < 2; ++b)
#pragma unroll
                for (int m = 0; m < 4; ++m)
#pragma unroll
                    for (int n = 0; n < 2; ++n) acc[a][b][m][n] = (f32x4){0.f, 0.f, 0.f, 0.f};
        cur = nxt; cA = nA; cB = nB; ++ui;
        if constexpr (ALIGN_EPI) { if (wr == 1) PG8_BAR; }
    }
    PG8_WAIT_V(0);
    if constexpr (!ALIGN_EPI) { if (wr == 0) PG8_BAR; }
    PG8_BAR;
#undef PG8_SA
#undef PG8_SB
#undef PG8_STAGE
#undef PG8_LDA
#undef PG8_LD8
#undef PG8_LDB
#undef PG8_MMA
#undef PG8_CAT8
#undef PG8_WAIT_V
#undef PG8_WAIT_L
#undef PG8_BAR
#undef PG8_SCHED
}

typedef const f32x4 (&AccRef)[2][2][4][2];
__device__ __forceinline__ u32x4 pack8(f32x4 v0, f32x4 v1) { u32x4 w; w.x = cvt_pk_bf16(v0[0], v0[1]); w.y = cvt_pk_bf16(v0[2], v0[3]); w.z = cvt_pk_bf16(v1[0], v1[1]); w.w = cvt_pk_bf16(v1[2], v1[3]); return w; }

template <bool F8> struct EpiSwiglu {
    static constexpr bool PERM = true;
    bf16_t* O;
    __device__ __forceinline__ void operator()(AccRef acc, const Unit& u, int wr, int wc, int fr, int fq) const {
        constexpr int col_base = F8 ? FIN_BF_TILES * 128 : 0; constexpr float sc = F8 ? 1.f / G8_SCALE : 1.f;
        const int row0 = u.pm * BM + wr * 64 + fr, col0 = col_base + u.pn * HALF + wc * 32 + 8 * fq;
#pragma unroll
        for (int ai = 0; ai < 2; ++ai)
#pragma unroll
            for (int m = 0; m < 4; ++m) {
                bf16_t* p = O + (size_t)(row0 + ai * HALF + m * 16) * DFF + col0;
                const f32x4 v0 = swiglu_pk4<F8>(acc[ai][0][m][0], acc[ai][1][m][0]), v1 = swiglu_pk4<F8>(acc[ai][0][m][1], acc[ai][1][m][1]);
                *(u32x4*)p = pack8(v0, v1);
                if constexpr (F8) asm volatile("" ::: "memory");
            }
    }
};
template <bool LN> struct EpiResidT {
    static constexpr bool PERM = false;
    const float* hin; float* R; const float* gate; float gs; const float* stats; const float* lng; const float* lnb;
    __device__ __forceinline__ void operator()(AccRef acc, const Unit& u, int wr, int wc, int fr, int fq) const {
        const int row0 = u.pm * BM + wr * 64 + fr, col0 = u.pn * BM + wc * 32 + 4 * fq;
        const float* gp = gate + (size_t)(u.pm >> 4) * NMOD + col0;
        f32x2_t st[2][4];
#pragma unroll
        for (int ai = 0; ai < 2; ++ai)
#pragma unroll
            for (int m = 0; m < 4; ++m) { if constexpr (LN) st[ai][m] = *(const f32x2_t*)(stats + 2 * (size_t)(row0 + ai * HALF + m * 16)); else st[ai][m] = (f32x2_t){0.f, 1.f}; }
#pragma unroll
        for (int bj = 0; bj < 2; ++bj)
#pragma unroll
            for (int n = 0; n < 2; ++n) {
                const int co = bj * HALF + 16 * n;
                const f32x4 gv = *(const f32x4*)(gp + co) * gs;
                f32x4 lg4 = (f32x4){1.f, 1.f, 1.f, 1.f}, lb4 = (f32x4){0.f, 0.f, 0.f, 0.f};
                if constexpr (LN) { lg4 = *(const f32x4*)(lng + col0 + co); lb4 = *(const f32x4*)(lnb + col0 + co); }
                f32x4 hv[2][4];
#pragma unroll
                for (int ai = 0; ai < 2; ++ai)
#pragma unroll
                    for (int m = 0; m < 4; ++m) hv[ai][m] = *(const f32x4*)(hin + (size_t)(row0 + ai * HALF + m * 16) * DM + col0 + co);
#pragma unroll
                for (int ai = 0; ai < 2; ++ai)
#pragma unroll
                    for (int m = 0; m < 4; ++m) { const size_t off = (size_t)(row0 + ai * HALF + m * 16) * DM + col0 + co;
                        f32x4 h = hv[ai][m];
                        if constexpr (LN) h = (h - st[ai][m][0]) * st[ai][m][1] * lg4 + lb4;
                        *(f32x4*)(R + off) = h * ALPHA + gv * acc[ai][bj][m][n]; }
            }
    }
};
struct EpiMix {
    static constexpr bool PERM = true;
    bf16_t* MIX; bf16_t* GATES;
    __device__ __forceinline__ void operator()(AccRef acc, const Unit& u, int wr, int wc, int fr, int fq) const {
        const int row0 = u.pm * BM + wr * 64 + fr; int colt = u.pn * BM; bf16_t* base = MIX; int ldc = MIXP;
        if (colt >= 6144) { base = GATES; ldc = GP; colt -= 6144; }
        const int col0 = colt + wc * 32 + 8 * fq;
#pragma unroll
        for (int ai = 0; ai < 2; ++ai)
#pragma unroll
            for (int m = 0; m < 4; ++m) { bf16_t* p = base + (size_t)(row0 + ai * HALF + m * 16) * ldc + col0;
#pragma unroll
                for (int bj = 0; bj < 2; ++bj) *(u32x4*)(p + bj * HALF) = pack8(acc[ai][bj][m][0], acc[ai][bj][m][1]); }
    }
};
struct EpiGates8 {
    static constexpr bool PERM = true;
    bf16_t* GATES;
    __device__ __forceinline__ void operator()(AccRef acc, const Unit& u, int wr, int wc, int fr, int fq) const {
        const int row0 = u.pm * BM + wr * 64 + fr, col0 = u.pn * BM + wc * 32 + 8 * fq; const float sc = 1.f / G8_SCALE;
#pragma unroll
        for (int ai = 0; ai < 2; ++ai)
#pragma unroll
            for (int m = 0; m < 4; ++m) { bf16_t* p = GATES + (size_t)(row0 + ai * HALF + m * 16) * GP + col0;
#pragma unroll
                for (int bj = 0; bj < 2; ++bj) *(u32x4*)(p + bj * HALF) = pack8(acc[ai][bj][m][0] * sc, acc[ai][bj][m][1] * sc); }
    }
};
template <bool SECOND> struct EpiGate {
    static constexpr bool PERM = true;
    const bf16_t* G;
    bf16_t* T;
    bf16_t* OUT;
    __device__ __forceinline__ void operator()(AccRef acc, const Unit& u, int wr, int wc, int fr, int fq) const {
        const int row0 = u.pm * BM + wr * 64 + fr, col0 = u.pn * BM + wc * 32 + 8 * fq;
#pragma unroll
        for (int ai = 0; ai < 2; ++ai)
#pragma unroll
            for (int bj = 0; bj < 2; ++bj) {
                u32x4 gw[4], tw[4];
#pragma unroll
                for (int m = 0; m < 4; ++m) { const size_t row = (size_t)(row0 + ai * HALF + m * 16);
                    gw[m] = *(const u32x4*)(G + row * GP + col0 + bj * HALF);
                    if constexpr (SECOND) tw[m] = *(const u32x4*)(T + row * DM + col0 + bj * HALF); }
#pragma unroll
                for (int m = 0; m < 4; ++m) { const size_t row = (size_t)(row0 + ai * HALF + m * 16);
                    f32x4 v0 = gate_pk4(acc[ai][bj][m][0], gw[m].x, gw[m].y), v1 = gate_pk4(acc[ai][bj][m][1], gw[m].z, gw[m].w);
                    if constexpr (SECOND) {
                        v0[0] += bf_lo(tw[m].x); v0[1] += bf_hi(tw[m].x); v0[2] += bf_lo(tw[m].y); v0[3] += bf_hi(tw[m].y);
                        v1[0] += bf_lo(tw[m].z); v1[1] += bf_hi(tw[m].z); v1[2] += bf_lo(tw[m].w); v1[3] += bf_hi(tw[m].w);
                        *(u32x4*)(OUT + row * MIXP + col0 + bj * HALF) = pack8(v0, v1);
                    } else {
                        *(u32x4*)(T + row * DM + col0 + bj * HALF) = pack8(v0, v1);
                    }
                }
            }
    }
};
}

struct Args { const float* in[22]; float* out; unsigned char* ws; int ph_lo, ph_hi; };
enum { I_X = 0, I_C, I_WADA, I_BADA, I_F1IN, I_F1OUT, I_LN1G, I_LN1B, I_WMIX, I_RELB, I_WA2, I_BAL, I_GNG, I_WPA, I_WPB, I_WMO, I_LN2G, I_LN2B, I_F2IN, I_F2OUT, I_LN3G, I_LN3B };

struct Ctx {
    LAS unsigned char* lds; int tid, lane, wave, G, bx;
    const Args* a;
};

__device__ __forceinline__ void tr_item(const float* W, int ldw, int K, int k0, int c0, bf16_t* WT, int r0, int ncols, LAS float* scr, int lane) {
    const int cl = lane & 31;
    float tv[32];
#pragma unroll
    for (int i = 0; i < 32; ++i) { const int kk = 2 * i + (lane >> 5); tv[i] = (cl < ncols) ? W[(size_t)(k0 + kk) * ldw + c0 + cl] : 0.f; }
#pragma unroll
    for (int i = 0; i < 32; ++i) { const int kk = 2 * i + (lane >> 5); scr[kk * 33 + cl] = tv[i]; }
    asm volatile("s_waitcnt lgkmcnt(0)" ::: "memory");
    const int c = lane & 7;
#pragma unroll
    for (int j = 0; j < 4; ++j) { const int n = (lane >> 3) + 8 * j; const LAS float* s = scr + (8 * c) * 33 + n;
        u32x4 o; o.x = cvt_pk_bf16(s[0 * 33], s[1 * 33]); o.y = cvt_pk_bf16(s[2 * 33], s[3 * 33]); o.z = cvt_pk_bf16(s[4 * 33], s[5 * 33]); o.w = cvt_pk_bf16(s[6 * 33], s[7 * 33]);
        if (n < ncols) *(u32x4*)(WT + (size_t)(r0 + n) * K + k0 + 8 * c) = o; }
    asm volatile("s_waitcnt lgkmcnt(0)" ::: "memory");
}

__device__ __forceinline__ unsigned pk4_fp8(float a, float b, float c, float d) { int w = 0; w = __builtin_amdgcn_cvt_pk_fp8_f32(a, b, w, false); w = __builtin_amdgcn_cvt_pk_fp8_f32(c, d, w, true); return (unsigned)w; }
__device__ __forceinline__ void tr_item8(const float* W, int ldw, int K, int k0, int c0, unsigned char* W8, int r0, LAS float* scr, int lane) {
    const int cl = lane & 31;
    float tv[32];
#pragma unroll
    for (int i = 0; i < 32; ++i) { const int kk = 2 * i + (lane >> 5); tv[i] = W[(size_t)(k0 + kk) * ldw + c0 + cl] * G8_SCALE; }
#pragma unroll
    for (int i = 0; i < 32; ++i) { const int kk = 2 * i + (lane >> 5); scr[kk * 33 + cl] = tv[i]; }
    asm volatile("s_waitcnt lgkmcnt(0)" ::: "memory");
    const int c = lane & 3;
#pragma unroll
    for (int j = 0; j < 2; ++j) { const int n = (lane >> 2) + 16 * j; const LAS float* s = scr + (16 * c) * 33 + n;
        u32x4 o; o.x = pk4_fp8(s[0 * 33], s[1 * 33], s[2 * 33], s[3 * 33]); o.y = pk4_fp8(s[4 * 33], s[5 * 33], s[6 * 33], s[7 * 33]);
        o.z = pk4_fp8(s[8 * 33], s[9 * 33], s[10 * 33], s[11 * 33]); o.w = pk4_fp8(s[12 * 33], s[13 * 33], s[14 * 33], s[15 * 33]);
        *(u32x4*)(W8 + (size_t)(r0 + n) * K + k0 + 16 * c) = o; }
    asm volatile("s_waitcnt lgkmcnt(0)" ::: "memory");
}

__device__ __forceinline__ void p0_prologue(const Ctx& X) {
    const Args& a = *X.a; unsigned char* ws = a.ws;
    LAS float* sl = (LAS float*)X.lds;
    LAS float* red = (LAS float*)(X.lds + 32768);
    for (int i = X.tid; i < 4 * DM; i += 512) sl[i] = fast_silu(a.in[I_C][i]);
    __syncthreads();
    float* mod = (float*)(ws + WS_MOD);
    for (int it = X.bx; it < NMOD / 64; it += X.G) {
        const int j0 = it * 64; const float* wp = a.in[I_WADA] + (size_t)(256 * X.wave) * NMOD + j0 + X.lane;
        float a0 = 0.f, a1 = 0.f, a2 = 0.f, a3 = 0.f;
        for (int k8 = 0; k8 < 256; k8 += 32) { float wv[32];
#pragma unroll
            for (int q = 0; q < 32; ++q) wv[q] = wp[(size_t)(k8 + q) * NMOD];
#pragma unroll
            for (int q = 0; q < 32; ++q) { const int k = 256 * X.wave + k8 + q; a0 += sl[k] * wv[q]; a1 += sl[DM + k] * wv[q]; a2 += sl[2 * DM + k] * wv[q]; a3 += sl[3 * DM + k] * wv[q]; } }
        red[(X.wave * 4 + 0) * 64 + X.lane] = a0; red[(X.wave * 4 + 1) * 64 + X.lane] = a1; red[(X.wave * 4 + 2) * 64 + X.lane] = a2; red[(X.wave * 4 + 3) * 64 + X.lane] = a3;
        __syncthreads();
        if (X.tid < 256) { const int b = X.tid >> 6, l = X.tid & 63; float s = a.in[I_BADA][j0 + l];
#pragma unroll
            for (int w = 0; w < 8; ++w) s += red[(w * 4 + b) * 64 + l];
            mod[(size_t)b * NMOD + j0 + l] = s; }
        __syncthreads();
    }
    __syncthreads();
    LAS float* scr = (LAS float*)(X.lds + X.wave * 16384);
    const int gw = X.bx * 8 + X.wave, NGW = X.G * 8;
    constexpr int I_FIN = 32 * 352, I_FOUT = 88 * 64, I_MIX = 32 * 320, I_LR = 32, I_P = 16 * 64, I_MO = 32 * 64;
    constexpr int NITEMS = 2 * I_FIN + 2 * I_FOUT + I_MIX + I_LR + 2 * I_P + I_MO;
    for (int it = gw; it < NITEMS; it += NGW) {
        int r = it;
        if (r < 2 * I_FIN) { const int which = r >= I_FIN; r -= which * I_FIN; const int kb = r / 352, nb = r % 352, c0 = 32 * nb, bj = c0 / DFF, j = c0 % DFF;
            const int rd = 256 * (j / 128) + 128 * bj + (j % 128);
            if (rd < FIN_BF_TILES * 256) tr_item(a.in[which ? I_F2IN : I_F1IN], 2 * DFF, DM, 64 * kb, c0, (bf16_t*)(ws + (which ? WS_W2IN : WS_W1IN)), rd, 32, scr, X.lane);
            else tr_item8(a.in[which ? I_F2IN : I_F1IN], 2 * DFF, DM, 64 * kb, c0, ws + (which ? WS_W2IN8 : WS_W1IN8), rd - FIN_BF_TILES * 256, scr, X.lane);
            continue; }
        r -= 2 * I_FIN;
        if (r < 2 * I_FOUT) { const int which = r >= I_FOUT; r -= which * I_FOUT; const int kb = r / 64, nb = r % 64;
            tr_item(a.in[which ? I_F2OUT : I_F1OUT], DM, DFF, 64 * kb, 32 * nb, (bf16_t*)(ws + (which ? WS_W2OUT : WS_W1OUT)), 32 * nb, 32, scr, X.lane); continue; }
        r -= 2 * I_FOUT;
        if (r < I_MIX) { const int kb = r / 320, nb = r % 320, r0 = 32 * nb, c0 = r0 < 6144 ? r0 : r0 + 16;
            if (r0 < 6144) tr_item(a.in[I_WMIX], WMIX_SRC_LD, DM, 64 * kb, c0, (bf16_t*)(ws + WS_WMIX), r0, 32, scr, X.lane);
            else tr_item8(a.in[I_WMIX], WMIX_SRC_LD, DM, 64 * kb, c0, ws + WS_WG8, r0 - 6144, scr, X.lane);
            continue; }
        r -= I_MIX;
        if (r < I_LR) { tr_item(a.in[I_WMIX], WMIX_SRC_LD, DM, 64 * r, 6144, (bf16_t*)(ws + WS_WLR), 0, 16, scr, X.lane); continue; }
        r -= I_LR;
        if (r < 2 * I_P) { const int which = r >= I_P; r -= which * I_P; const int kb = r / 64, nb = r % 64;
            tr_item(a.in[which ? I_WPB : I_WPA], DM, 1024, 64 * kb, 32 * nb, (bf16_t*)(ws + (which ? WS_WPB : WS_WPA)), 32 * nb, 32, scr, X.lane); continue; }
        r -= 2 * I_P;
        { const int kb = r / 64, nb = r % 64; tr_item(a.in[I_WMO], DM, DM, 64 * kb, 32 * nb, (bf16_t*)(ws + WS_WMO), 32 * nb, 32, scr, X.lane); }
    }
}

__device__ __forceinline__ void p_modulate(const Ctx& X, const float* x, const float* mod, int sh_off, bf16_t* U, unsigned char* U8) {
    const size_t n8 = (size_t)M_TOK * DM / 8, stride = (size_t)X.G * 512;
    for (size_t i0 = (size_t)X.bx * 512 + X.tid; i0 < n8; i0 += 2 * stride) {
        const size_t i1 = i0 + stride; const bool two = i1 < n8;
        const int rowa = (int)(i0 >> 8), ca = (int)(i0 & 255) * 8, rowb = two ? (int)(i1 >> 8) : rowa, cb = two ? (int)(i1 & 255) * 8 : ca;
        const float* ma = mod + (size_t)(rowa >> 12) * NMOD + sh_off + ca; const float* mb = mod + (size_t)(rowb >> 12) * NMOD + sh_off + cb;
        const f32x4 xa0 = *(const f32x4*)(x + (size_t)rowa * DM + ca), xa1 = *(const f32x4*)(x + (size_t)rowa * DM + ca + 4), xb0 = *(const f32x4*)(x + (size_t)rowb * DM + cb), xb1 = *(const f32x4*)(x + (size_t)rowb * DM + cb + 4);
        const f32x4 sa0 = *(const f32x4*)(ma), sa1 = *(const f32x4*)(ma + 4), ka0 = *(const f32x4*)(ma + DM), ka1 = *(const f32x4*)(ma + DM + 4);
        const f32x4 sb0 = *(const f32x4*)(mb), sb1 = *(const f32x4*)(mb + 4), kb0 = *(const f32x4*)(mb + DM), kb1 = *(const f32x4*)(mb + DM + 4);
        { const f32x4 u0 = xa0 * (1.f + ka0) + sa0, u1 = xa1 * (1.f + ka1) + sa1;
          *(u32x4*)(U + (size_t)rowa * DM + ca) = pg8::pack8(u0, u1);
          u32x2 w8; w8.x = pk4_fp8(u0[0], u0[1], u0[2], u0[3]); w8.y = pk4_fp8(u1[0], u1[1], u1[2], u1[3]); *(u32x2*)(U8 + (size_t)rowa * DM + ca) = w8; }
        if (two) { const f32x4 u0 = xb0 * (1.f + kb0) + sb0, u1 = xb1 * (1.f + kb1) + sb1;
          *(u32x4*)(U + (size_t)rowb * DM + cb) = pg8::pack8(u0, u1);
          u32x2 w8; w8.x = pk4_fp8(u0[0], u0[1], u0[2], u0[3]); w8.y = pk4_fp8(u1[0], u1[1], u1[2], u1[3]); *(u32x2*)(U8 + (size_t)rowb * DM + cb) = w8; }
    }
}

template <bool LAST, bool F8 = false>
__device__ __forceinline__ void p_layernorm(const Ctx& X, const float* R, const float* lg, const float* lb, float* Hout, float* stats, const float* mod, int sh_off, bf16_t* U, unsigned char* U8 = nullptr) {
    const int gw = X.bx * 8 + X.wave, NGW = X.G * 8;
    f32x4 vn[8];
    if (gw < M_TOK) {
#pragma unroll
        for (int j = 0; j < 8; ++j) vn[j] = *(const f32x4*)(R + (size_t)gw * DM + 4 * X.lane + 256 * j);
    }
    for (int row = gw; row < M_TOK; row += NGW) {
        f32x4 v[8]; float s = 0.f;
#pragma unroll
        for (int j = 0; j < 8; ++j) { v[j] = vn[j]; s += (v[j][0] + v[j][1]) + (v[j][2] + v[j][3]); }
        if (row + NGW < M_TOK) {
#pragma unroll
            for (int j = 0; j < 8; ++j) vn[j] = *(const f32x4*)(R + (size_t)(row + NGW) * DM + 4 * X.lane + 256 * j);
        }
        const float mean = wave_sum(s) * (1.f / DM); float s2 = 0.f;
#pragma unroll
        for (int j = 0; j < 8; ++j) { v[j] = v[j] - mean; s2 += (v[j][0] * v[j][0] + v[j][1] * v[j][1]) + (v[j][2] * v[j][2] + v[j][3] * v[j][3]); }
        const float rstd = 1.f / sqrtf(wave_sum(s2) * (1.f / DM) + LN_EPS);
        const float* mp = LAST ? nullptr : mod + (size_t)(row >> 12) * NMOD + sh_off + 4 * X.lane;
        if constexpr (!LAST) { if (X.lane == 0) *(f32x2_t*)(stats + 2 * (size_t)row) = (f32x2_t){mean, rstd}; }
#pragma unroll
        for (int j = 0; j < 8; ++j) {
            const f32x4 g4 = *(const f32x4*)(lg + 4 * X.lane + 256 * j), b4 = *(const f32x4*)(lb + 4 * X.lane + 256 * j);
            const f32x4 y = v[j] * rstd * g4 + b4;
            if constexpr (LAST) *(f32x4*)(Hout + (size_t)row * DM + 4 * X.lane + 256 * j) = y;
            if constexpr (!LAST) { const f32x4 sh = *(const f32x4*)(mp + 256 * j), sc = *(const f32x4*)(mp + DM + 256 * j); const f32x4 uu = y * (1.f + sc) + sh;
                u32x2 w; w.x = cvt_pk_bf16(uu[0], uu[1]); w.y = cvt_pk_bf16(uu[2], uu[3]); *(u32x2*)(U + (size_t)row * DM + 4 * X.lane + 256 * j) = w;
                if constexpr (F8) *(unsigned*)(U8 + (size_t)row * DM + 4 * X.lane + 256 * j) = pk4_fp8(uu[0], uu[1], uu[2], uu[3]); }
        }
    }
}

__device__ __forceinline__ s16x4 tr_read(const LAS unsigned char* p) { return __builtin_bit_cast(s16x4, __builtin_amdgcn_ds_read_tr16_b64_v4i16((LAS s16x4*)p)); }
__device__ __forceinline__ bf16x8 cat8(s16x4 a, s16x4 b) { return (bf16x8){a[0], a[1], a[2], a[3], b[0], b[1], b[2], b[3]}; }

constexpr int KD_P = 1088, V_P = 576, OT_P = 528;
constexpr int L1_RED = 0, L1_LRS = 32768, L1_KD = 36864, L1_V = L1_KD + 64 * KD_P, L1_END = L1_V + 64 * V_P;
static_assert(L1_END <= 147456, "gla chunk LDS");

__device__ __forceinline__ void p_gla_chunk(const Ctx& X, const bf16_t* U, const bf16_t* WLR, const bf16_t* MIX, float* DEC, bf16_t* UB, const float* wa2, const float* bal) {
    LAS unsigned char* lds = X.lds;
    LAS float* red = (LAS float*)(lds + L1_RED);
    LAS float* lrs = (LAS float*)(lds + L1_LRS);
    const int tid = X.tid, lane = X.lane, w = X.wave, l15 = lane & 15, g = lane >> 4;
    const int tr_row = 8 * g + (l15 >> 2), tr_col = 4 * (l15 & 3);
    const int vr = tid >> 5, vc = tid & 31;
    for (int ch = X.bx; ch < 256; ch += X.G) {
        const size_t t0 = (size_t)ch * 64;
        f32x4 acc[4];
#pragma unroll
        for (int mi = 0; mi < 4; ++mi) acc[mi] = (f32x4){0.f, 0.f, 0.f, 0.f};
        const int kw = 256 * w + 8 * g;
#pragma unroll
        for (int s = 0; s < 8; ++s) {
            const bf16x8 bfr = *(const bf16x8*)(WLR + (size_t)l15 * DM + kw + 32 * s);
#pragma unroll
            for (int mi = 0; mi < 4; ++mi) { const bf16x8 afr = *(const bf16x8*)(U + (t0 + 16 * mi + l15) * DM + kw + 32 * s);
                acc[mi] = __builtin_amdgcn_mfma_f32_16x16x32_bf16(afr, bfr, acc[mi], 0, 0, 0); }
        }
#pragma unroll
        for (int mi = 0; mi < 4; ++mi)
#pragma unroll
            for (int e = 0; e < 4; ++e) red[(w * 64 + 16 * mi + 4 * g + e) * 16 + l15] = acc[mi][e];
        __syncthreads();
        for (int i = tid; i < 1024; i += 512) { float s = 0.f;
#pragma unroll
            for (int ww = 0; ww < 8; ++ww) s += red[ww * 1024 + i];
            lrs[i] = s; }
        __syncthreads();
        {   const int kp = tid;
            float wa[16];
#pragma unroll
            for (int r = 0; r < 16; ++r) wa[r] = wa2[r * 512 + kp];
            const float ba = bal[kp];
            float cum[64]; float run = 0.f;
#pragma unroll
            for (int c = 0; c < 64; ++c) {
                float z = ba;
#pragma unroll
                for (int r4 = 0; r4 < 4; ++r4) { const f32x4 l4 = *(const LAS f32x4*)(lrs + c * 16 + 4 * r4);
                    z += l4[0] * wa[4 * r4] + l4[1] * wa[4 * r4 + 1] + l4[2] * wa[4 * r4 + 2] + l4[3] * wa[4 * r4 + 3]; }
                const float ls = fminf(z, 0.f) - __logf(1.f + __expf(-fabsf(z)));
                run += ls * (1.f / 16.f); cum[c] = run;
            }
            DEC[(size_t)ch * 512 + kp] = __expf(run);
            const bf16_t* kptr = MIX + t0 * MIXP + C_KB + kp;
#pragma unroll
            for (int c = 0; c < 64; ++c) { const float kv = __uint_as_float((unsigned)kptr[(size_t)c * MIXP] << 16); const float kd = kv * __expf(run - cum[c]);
                *(LAS bf16_t*)(lds + L1_KD + c * KD_P + kp * 2) = (bf16_t)(cvt_pk_bf16(kd, 0.f) & 0xffffu); }
        }
        for (int h = 0; h < 4; ++h) {
            u32x4 pv[4];
#pragma unroll
            for (int i = 0; i < 4; ++i) pv[i] = *(const u32x4*)(MIX + (t0 + vr + 16 * i) * MIXP + C_VB + h * 256 + vc * 8);
            __syncthreads();
#pragma unroll
            for (int i = 0; i < 4; ++i) *(LAS u32x4*)(lds + L1_V + (vr + 16 * i) * V_P + vc * 16) = pv[i];
            __syncthreads();
            f32x4 uacc[2][8];
#pragma unroll
            for (int vt = 0; vt < 2; ++vt)
#pragma unroll
                for (int kt = 0; kt < 8; ++kt) uacc[vt][kt] = (f32x4){0.f, 0.f, 0.f, 0.f};
#pragma unroll
            for (int s = 0; s < 2; ++s) {
                bf16x8 va[2];
#pragma unroll
                for (int vt = 0; vt < 2; ++vt) { const LAS unsigned char* p = lds + L1_V + (32 * s + tr_row) * V_P + (32 * w + 16 * vt + tr_col) * 2; va[vt] = cat8(tr_read(p), tr_read(p + 4 * V_P)); }
#pragma unroll
                for (int kt = 0; kt < 8; ++kt) { const LAS unsigned char* p = lds + L1_KD + (32 * s + tr_row) * KD_P + (h * 128 + 16 * kt + tr_col) * 2;
                    const bf16x8 kf = cat8(tr_read(p), tr_read(p + 4 * KD_P));
                    uacc[0][kt] = __builtin_amdgcn_mfma_f32_16x16x32_bf16(va[0], kf, uacc[0][kt], 0, 0, 0);
                    uacc[1][kt] = __builtin_amdgcn_mfma_f32_16x16x32_bf16(va[1], kf, uacc[1][kt], 0, 0, 0); }
            }
            bf16_t* up = UB + ((size_t)(ch * 4 + h) * 128) * 256;
#pragma unroll
            for (int vt = 0; vt < 2; ++vt)
#pragma unroll
                for (int kt = 0; kt < 8; ++kt) { u32x2 o; o.x = cvt_pk_bf16(uacc[vt][kt][0], uacc[vt][kt][1]); o.y = cvt_pk_bf16(uacc[vt][kt][2], uacc[vt][kt][3]);
                    *(u32x2*)(up + (size_t)(16 * kt + l15) * 256 + 32 * w + 16 * vt + 4 * g) = o; }
        }
        __syncthreads();
    }
}

__device__ __forceinline__ void p_gla_scan_elem(const Ctx& X, const float* DEC, const bf16_t* UB, bf16_t* ST) {
    for (int idx = X.bx * 512 + X.tid; idx < 4 * 4 * 128 * 64; idx += X.G * 512) {
        const int vq = idx & 63, k = (idx >> 6) & 127, h = (idx >> 13) & 3, b = idx >> 15;
        const size_t off0 = ((size_t)((b * 64) * 4 + h) * 128 + k) * 256 + 4 * vq;
        const bf16_t* p0 = UB + off0; bf16_t* s0 = ST + off0;
        const float* d0 = DEC + (size_t)(b * 64) * 512 + h * 128 + k;
        f32x4 st = (f32x4){0.f, 0.f, 0.f, 0.f};
        for (int n8 = 0; n8 < 64; n8 += 8) {
            u32x2 uv[8]; float dv[8];
#pragma unroll
            for (int q = 0; q < 8; ++q) { uv[q] = *(const u32x2*)(p0 + (size_t)(n8 + q) * (4 * 128 * 256)); dv[q] = d0[(size_t)(n8 + q) * 512]; }
#pragma unroll
            for (int q = 0; q < 8; ++q) { const f32x4 uu = (f32x4){bf_lo(uv[q].x), bf_hi(uv[q].x), bf_lo(uv[q].y), bf_hi(uv[q].y)}; st = st * dv[q] + uu;
                u32x2 o; o.x = cvt_pk_bf16(st[0], st[1]); o.y = cvt_pk_bf16(st[2], st[3]); *(u32x2*)(s0 + (size_t)(n8 + q) * (4 * 128 * 256)) = o; }
        }
    }
}

constexpr int L3_S = 0, L3_SS = 128 * V_P, L3_OT = L3_SS + 2048, L3_END = L3_OT + 64 * OT_P;
static_assert(L3_END <= 131072, "gla readout LDS");
__device__ __forceinline__ void p_gla_readout(const Ctx& X, bf16_t* MIX, const bf16_t* UB, const float* gng) {
    LAS unsigned char* lds = X.lds;
    const int tid = X.tid, lane = X.lane, w = X.wave, l15 = lane & 15, g = lane >> 4;
    const int tr_row = 8 * g + (l15 >> 2), tr_col = 4 * (l15 & 3);
    const int vr = tid >> 5, vc = tid & 31;
    const float qscale = 0.08838834764831845f;
    for (int uid = X.bx; uid < 1024; uid += X.G) {
        const int ch = uid >> 2, h = uid & 3; const size_t t0 = (size_t)ch * 64;
        const bf16_t* sp = UB + ((size_t)(ch * 4 + h) * 128) * 256;
        u32x4 sv[8], rbv[4];
#pragma unroll
        for (int i = 0; i < 8; ++i) sv[i] = *(const u32x4*)(sp + (size_t)(vr + 16 * i) * 256 + vc * 8);
#pragma unroll
        for (int i = 0; i < 4; ++i) rbv[i] = *(const u32x4*)(MIX + (t0 + vr + 16 * i) * MIXP + C_RB + h * 256 + vc * 8);
        bf16x8 qf[4][4];
#pragma unroll
        for (int mc = 0; mc < 4; ++mc)
#pragma unroll
            for (int s = 0; s < 4; ++s) qf[mc][s] = *(const bf16x8*)(MIX + (t0 + 16 * mc + l15) * MIXP + C_QB + h * 128 + 32 * s + 8 * g);
#pragma unroll
        for (int i = 0; i < 8; ++i) *(LAS u32x4*)(lds + L3_S + (vr + 16 * i) * V_P + vc * 16) = sv[i];
        __syncthreads();
        f32x4 o[4][2];
#pragma unroll
        for (int mc = 0; mc < 4; ++mc) { o[mc][0] = (f32x4){0.f, 0.f, 0.f, 0.f}; o[mc][1] = (f32x4){0.f, 0.f, 0.f, 0.f}; }
#pragma unroll
        for (int s = 0; s < 4; ++s) {
            bf16x8 sb[2];
#pragma unroll
            for (int nt = 0; nt < 2; ++nt) { const LAS unsigned char* p = lds + L3_S + (32 * s + tr_row) * V_P + (32 * w + 16 * nt + tr_col) * 2; sb[nt] = cat8(tr_read(p), tr_read(p + 4 * V_P)); }
#pragma unroll
            for (int mc = 0; mc < 4; ++mc) { o[mc][0] = __builtin_amdgcn_mfma_f32_16x16x32_bf16(qf[mc][s], sb[0], o[mc][0], 0, 0, 0);
                o[mc][1] = __builtin_amdgcn_mfma_f32_16x16x32_bf16(qf[mc][s], sb[1], o[mc][1], 0, 0, 0); }
        }
#pragma unroll
        for (int mc = 0; mc < 4; ++mc) { f32x4 q2 = o[mc][0] * o[mc][0] + o[mc][1] * o[mc][1];
#pragma unroll
            for (int sh = 1; sh < 16; sh <<= 1) { q2[0] += __shfl_xor(q2[0], sh); q2[1] += __shfl_xor(q2[1], sh); q2[2] += __shfl_xor(q2[2], sh); q2[3] += __shfl_xor(q2[3], sh); }
            if (l15 == 0) *(LAS f32x4*)(lds + L3_SS + (w * 64 + 16 * mc + 4 * g) * 4) = q2; }
        __syncthreads();
#pragma unroll
        for (int mc = 0; mc < 4; ++mc) { f32x4 tot = (f32x4){0.f, 0.f, 0.f, 0.f};
#pragma unroll
            for (int ww = 0; ww < 8; ++ww) tot += *(const LAS f32x4*)(lds + L3_SS + (ww * 64 + 16 * mc + 4 * g) * 4);
#pragma unroll
            for (int e = 0; e < 4; ++e) { const float rs = qscale * __builtin_amdgcn_rsqf(tot[e] * (qscale * qscale / 256.f) + RMS_EPS);
#pragma unroll
                for (int nt = 0; nt < 2; ++nt) *(LAS bf16_t*)(lds + L3_OT + (16 * mc + 4 * g + e) * OT_P + (32 * w + 16 * nt + l15) * 2) = (bf16_t)(cvt_pk_bf16(o[mc][nt][e] * rs, 0.f) & 0xffffu); } }
        __syncthreads();
#pragma unroll
        for (int i = 0; i < 4; ++i) { const int row = vr + 16 * i; const u32x4 ot = *(const LAS u32x4*)(lds + L3_OT + row * OT_P + vc * 16);
            const f32x4 g0 = *(const f32x4*)(gng + vc * 8), g1 = *(const f32x4*)(gng + vc * 8 + 4); const u32x4 rb = rbv[i];
            f32x4 y0, y1;
            y0[0] = bf_lo(ot.x) * g0[0] * fast_silu(bf_lo(rb.x)); y0[1] = bf_hi(ot.x) * g0[1] * fast_silu(bf_hi(rb.x)); y0[2] = bf_lo(ot.y) * g0[2] * fast_silu(bf_lo(rb.y)); y0[3] = bf_hi(ot.y) * g0[3] * fast_silu(bf_hi(rb.y));
            y1[0] = bf_lo(ot.z) * g1[0] * fast_silu(bf_lo(rb.z)); y1[1] = bf_hi(ot.z) * g1[1] * fast_silu(bf_hi(rb.z)); y1[2] = bf_lo(ot.w) * g1[2] * fast_silu(bf_lo(rb.w)); y1[3] = bf_hi(ot.w) * g1[3] * fast_silu(bf_hi(rb.w));
            *(u32x4*)(MIX + (t0 + row) * MIXP + C_RB + h * 256 + vc * 8) = pg8::pack8(y0, y1); }
    }
}

__device__ __forceinline__ int crow(int r, int hi) { return (r & 3) + 8 * (r >> 2) + 4 * hi; }
constexpr int AV_P = 192, A_WAVE_BYTES = 64 * AV_P + 256, L_ABIAS = 8 * A_WAVE_BYTES;
static_assert(L_ABIAS + 16 * 320 * 4 <= 131072, "attention LDS");

__device__ __forceinline__ void attn_unit(const Ctx& X, bf16_t* MIX, int b, int h, int n, int half) {
    const int lane = X.lane, r32 = lane & 31, hi = lane >> 5;
    LAS unsigned char* wl = X.lds + X.wave * A_WAVE_BYTES;
    LAS float* wsf = (LAS float*)(wl + 64 * AV_P);
    const LAS float* bias2 = (const LAS float*)(X.lds + L_ABIAS) + h * 320;
    const size_t trow0 = (size_t)b * SEQ + n * 64 + half * 32;
    bf16x8 qr[4];
    { const bf16_t* Qp = MIX + (trow0 + r32) * MIXP + C_QA + h * 64 + hi * 8;
#pragma unroll
      for (int d0 = 0; d0 < 4; ++d0) qr[d0] = *(const bf16x8*)(Qp + d0 * 16); }
    f32x16 o0, o1;
#pragma unroll
    for (int r = 0; r < 16; ++r) { o0[r] = 0.f; o1[r] = 0.f; }
    float mrun = -1e30f, lrun = 0.f;
    const int vbase = (4 * hi + ((lane & 15) >> 2)) * AV_P + (16 * ((lane >> 4) & 1) + 4 * (lane & 3)) * 2;
    const float sc2 = 0.125f * LOG2E;
    const int j0 = (n >= 8 ? 0 : 8 - n);
    bf16x8 k0[4], k1[4]; u32x4 vv[8];
#define ATT_LOAD(j_) do { const size_t kv0_ = (size_t)b * SEQ + (size_t)(n - 8 + (j_)) * 64; \
        const bf16_t* Kp_ = MIX + (kv0_ + r32) * MIXP + C_KA + h * 64 + hi * 8; \
        _Pragma("unroll") for (int d0 = 0; d0 < 4; ++d0) { k0[d0] = *(const bf16x8*)(Kp_ + d0 * 16); k1[d0] = *(const bf16x8*)(Kp_ + (size_t)32 * MIXP + d0 * 16); } \
        const bf16_t* Vp_ = MIX + (kv0_ + (lane >> 3)) * MIXP + C_VA + h * 64 + (lane & 7) * 8; \
        _Pragma("unroll") for (int i = 0; i < 8; ++i) vv[i] = *(const u32x4*)(Vp_ + (size_t)(8 * i) * MIXP); } while (0)
    ATT_LOAD(j0);
    for (int j = j0; j < 9; ++j) {
#pragma unroll
        for (int i = 0; i < 8; ++i) *(LAS u32x4*)(wl + (8 * i + (lane >> 3)) * AV_P + (lane & 7) * 16) = vv[i];
        bf16x8 kc0[4], kc1[4];
#pragma unroll
        for (int d0 = 0; d0 < 4; ++d0) { kc0[d0] = k0[d0]; kc1[d0] = k1[d0]; }
        if (j + 1 < 9) ATT_LOAD(j + 1);
        f32x16 p0, p1;
#pragma unroll
        for (int r = 0; r < 16; ++r) { p0[r] = 0.f; p1[r] = 0.f; }
#pragma unroll
        for (int d0 = 0; d0 < 4; ++d0) { p0 = __builtin_amdgcn_mfma_f32_32x32x16_bf16(kc0[d0], qr[d0], p0, 0, 0, 0); p1 = __builtin_amdgcn_mfma_f32_32x32x16_bf16(kc1[d0], qr[d0], p1, 0, 0, 0); }
        if (j <= 3) { const float bc = bias2[0];
#pragma unroll
            for (int r = 0; r < 16; ++r) { p0[r] = p0[r] * sc2 + bc; p1[r] = p1[r] * sc2 + bc; }
        } else { const int rb = (j - 8) * 64 - (32 * half + r32) + 4 * hi + 256;
#pragma unroll
            for (int r = 0; r < 16; ++r) { const int c = (r & 3) + 8 * (r >> 2); const int i0 = max(rb + c, 0), i1 = max(rb + c + 32, 0);
                p0[r] = p0[r] * sc2 + bias2[i0]; p1[r] = p1[r] * sc2 + bias2[i1]; }
        }
        float mx = fmaxf(p0[0], p1[0]);
#pragma unroll
        for (int r = 1; r < 16; ++r) mx = fmaxf(mx, fmaxf(p0[r], p1[r]));
        mx = fmaxf(mx, __shfl_xor(mx, 32));
        const float mnew = fmaxf(mrun, mx), alpha = __builtin_amdgcn_exp2f(mrun - mnew); mrun = mnew;
        float rs = 0.f;
#pragma unroll
        for (int r = 0; r < 16; ++r) { p0[r] = __builtin_amdgcn_exp2f(p0[r] - mnew); p1[r] = __builtin_amdgcn_exp2f(p1[r] - mnew); rs += p0[r] + p1[r]; }
        lrun = lrun * alpha + rs;
        if (!__all(alpha == 1.0f)) {
        wsf[r32] = alpha;
#pragma unroll
        for (int g4 = 0; g4 < 4; ++g4) { const f32x4 a4 = *(const LAS f32x4*)(wsf + 8 * g4 + 4 * hi);
#pragma unroll
            for (int e = 0; e < 4; ++e) { o0[4 * g4 + e] *= a4[e]; o1[4 * g4 + e] *= a4[e]; } }
        }
        bf16x8 pa[4];
        { u32x4 t;
          t.x = cvt_pk_bf16(p0[0], p0[1]); t.y = cvt_pk_bf16(p0[2], p0[3]); t.z = cvt_pk_bf16(p0[4], p0[5]); t.w = cvt_pk_bf16(p0[6], p0[7]); pa[0] = __builtin_bit_cast(bf16x8, t);
          t.x = cvt_pk_bf16(p0[8], p0[9]); t.y = cvt_pk_bf16(p0[10], p0[11]); t.z = cvt_pk_bf16(p0[12], p0[13]); t.w = cvt_pk_bf16(p0[14], p0[15]); pa[1] = __builtin_bit_cast(bf16x8, t);
          t.x = cvt_pk_bf16(p1[0], p1[1]); t.y = cvt_pk_bf16(p1[2], p1[3]); t.z = cvt_pk_bf16(p1[4], p1[5]); t.w = cvt_pk_bf16(p1[6], p1[7]); pa[2] = __builtin_bit_cast(bf16x8, t);
          t.x = cvt_pk_bf16(p1[8], p1[9]); t.y = cvt_pk_bf16(p1[10], p1[11]); t.z = cvt_pk_bf16(p1[12], p1[13]); t.w = cvt_pk_bf16(p1[14], p1[15]); pa[3] = __builtin_bit_cast(bf16x8, t); }
#pragma unroll
        for (int kk = 0; kk < 4; ++kk) { const LAS unsigned char* p = wl + vbase + (16 * kk) * AV_P;
            const bf16x8 v0 = cat8(tr_read(p), tr_read(p + 8 * AV_P)), v1 = cat8(tr_read(p + 64), tr_read(p + 8 * AV_P + 64));
            o0 = __builtin_amdgcn_mfma_f32_32x32x16_bf16(pa[kk], v0, o0, 0, 0, 0);
            o1 = __builtin_amdgcn_mfma_f32_32x32x16_bf16(pa[kk], v1, o1, 0, 0, 0); }
    }
#undef ATT_LOAD
    lrun += __shfl_xor(lrun, 32);
    wsf[r32] = 1.f / lrun;
#pragma unroll
    for (int g4 = 0; g4 < 4; ++g4) { const f32x4 a4 = *(const LAS f32x4*)(wsf + 8 * g4 + 4 * hi);
#pragma unroll
        for (int e = 0; e < 4; ++e) { const int q = 8 * g4 + 4 * hi + e;
            *(LAS bf16_t*)(wl + q * 144 + r32 * 2) = (bf16_t)(cvt_pk_bf16(o0[4 * g4 + e] * a4[e], 0.f) & 0xffffu);
            *(LAS bf16_t*)(wl + q * 144 + 64 + r32 * 2) = (bf16_t)(cvt_pk_bf16(o1[4 * g4 + e] * a4[e], 0.f) & 0xffffu); } }
#pragma unroll
    for (int i = 0; i < 4; ++i) { const int row = 8 * i + (lane >> 3), chn = lane & 7; const u32x4 v = *(const LAS u32x4*)(wl + row * 144 + chn * 16);
        *(u32x4*)(MIX + (trow0 + row) * MIXP + C_QA + h * 64 + chn * 8) = v; }
}


#define XB_TMO      128
#define XB_XCNT(j)  (256  + 64 * (j))
#define XB_XSUB(j)  (1280 + 64 * (j))
#define XB_XGEN(j)  (2304 + 64 * (j))
#define XB_TOP      3328
#define XB_TOPGEN   3392
#define XCD_BAR_WORDS 3456
#define XB_SPIN_CAP (1u << 18)
__device__ __forceinline__ unsigned xb_ld(unsigned* p)              { return __hip_atomic_load(p, __ATOMIC_RELAXED, __HIP_MEMORY_SCOPE_AGENT); }
__device__ __forceinline__ unsigned xb_add(unsigned* p, unsigned v) { return __hip_atomic_fetch_add(p, v, __ATOMIC_RELAXED, __HIP_MEMORY_SCOPE_AGENT); }
__device__ __forceinline__ unsigned xb_xcc_id() { return (unsigned)__builtin_amdgcn_s_getreg((3 << 11) | 20) & 0xFu; }
#define XB_SPIN(cond, bar) do { unsigned _sp = 0; while (cond) { __builtin_amdgcn_s_sleep(1); \
    if ((++_sp & 255u) == 0u) { if (xb_ld(&(bar)[XB_TMO])) break; if (_sp > XB_SPIN_CAP) { atomicAdd(&(bar)[XB_TMO], 1u); break; } } } } while (0)
struct XcdBarrier { unsigned* bar; unsigned x; volatile LAS unsigned* st; };
__device__ __forceinline__ XcdBarrier xcd_barrier_post(unsigned* bar, volatile LAS unsigned* st) {
    XcdBarrier b; b.bar = bar; b.x = xb_xcc_id(); b.st = st;
    if (threadIdx.x == 0) (void)xb_add(&bar[XB_XCNT(b.x)], 1u);
    return b;
}
__device__ __forceinline__ void xcd_barrier_complete(unsigned* bar, unsigned x, unsigned& nloc, unsigned& nx) {
    const unsigned G = gridDim.x * gridDim.y * gridDim.z;
    unsigned sum, cnt, mine, sp = 0u;
    for (;;) {
        sum = 0u; cnt = 0u; mine = 0u;
#pragma unroll
        for (unsigned j = 0; j < 16; ++j) { const unsigned c = xb_ld(&bar[XB_XCNT(j)]); sum += c; cnt += (c > 0u) ? 1u : 0u; mine = (j == x) ? c : mine; }
        if (sum == G) break;
        __builtin_amdgcn_s_sleep(1);
        if ((++sp & 255u) == 0u) { if (xb_ld(&bar[XB_TMO])) break; if (sp > XB_SPIN_CAP) { atomicAdd(&bar[XB_TMO], 1u); break; } }
    }
    nloc = mine > 0u ? mine : 1u; nx = cnt > 0u ? cnt : 1u;
}
__device__ __forceinline__ void xcd_barrier(const XcdBarrier& b) {
    asm volatile("s_waitcnt vmcnt(0)" ::: "memory");
    __syncthreads();
    if (threadIdx.x == 0) {
        unsigned* bar = b.bar;
        __builtin_amdgcn_s_waitcnt(0);
        unsigned nloc = b.st[0], nx = b.st[1];
        if (nloc == 0u) { xcd_barrier_complete(bar, b.x, nloc, nx); b.st[0] = nloc; b.st[1] = nx; }
        const unsigned old = xb_add(&bar[XB_XSUB(b.x)], 1u);
        const unsigned gen = old / nloc;
        if (old + 1u == (gen + 1u) * nloc) {
            __builtin_amdgcn_fence(__ATOMIC_RELEASE, "agent");
            asm volatile("s_waitcnt vmcnt(0)" ::: "memory");
            const unsigned og = xb_add(&bar[XB_TOP], 1u);
            const unsigned tg = og / nx;
            if (og + 1u == (tg + 1u) * nx) xb_add(&bar[XB_TOPGEN], 1u);
            else XB_SPIN(xb_ld(&bar[XB_TOPGEN]) == tg, bar);
            __builtin_amdgcn_fence(__ATOMIC_ACQUIRE, "agent");
            xb_add(&bar[XB_XGEN(b.x)], 1u);
            asm volatile("s_waitcnt vmcnt(0)" ::: "memory");
        } else {
            XB_SPIN(xb_ld(&bar[XB_XGEN(b.x)]) == gen, bar);
            __builtin_amdgcn_fence(__ATOMIC_ACQUIRE, "agent");
            asm volatile("s_waitcnt vmcnt(0)" ::: "memory");
        }
    }
    __syncthreads();
}

__global__ void __launch_bounds__(512, 2) fwd_megakernel(Args args) {
    extern __shared__ __attribute__((aligned(16))) unsigned char lds_raw[];
    Ctx X; X.lds = (LAS unsigned char*)lds_raw; X.tid = threadIdx.x; X.lane = X.tid & 63; X.wave = __builtin_amdgcn_readfirstlane(X.tid >> 6); X.G = gridDim.x; X.bx = blockIdx.x; X.a = &args;
    unsigned char* ws = args.ws;
    float* mod = (float*)(ws + WS_MOD); float* DEC = (float*)(ws + WS_DEC);
    bf16_t* W1IN = (bf16_t*)(ws + WS_W1IN); bf16_t* W1OUT = (bf16_t*)(ws + WS_W1OUT); bf16_t* WMIX = (bf16_t*)(ws + WS_WMIX); bf16_t* WLR = (bf16_t*)(ws + WS_WLR);
    bf16_t* WPA = (bf16_t*)(ws + WS_WPA); bf16_t* WPB = (bf16_t*)(ws + WS_WPB); bf16_t* WMO = (bf16_t*)(ws + WS_WMO); bf16_t* W2IN = (bf16_t*)(ws + WS_W2IN); bf16_t* W2OUT = (bf16_t*)(ws + WS_W2OUT);
    bf16_t* U = (bf16_t*)(ws + WS_U); float* H = (float*)(ws + WS_H); bf16_t* ACT = (bf16_t*)(ws + WS_BIG); bf16_t* MIX = (bf16_t*)(ws + WS_BIG); bf16_t* UB = (bf16_t*)(ws + WS_UB); unsigned char* U8 = ws + WS_UB;     bf16_t* ST = (bf16_t*)(ws + WS_W1IN);
    float* R = args.out; bf16_t* GATES = (bf16_t*)(ws + WS_H); float* STATS = (float*)(ws + WS_STAT);
    const int lo = args.ph_lo, hi = args.ph_hi;
    cg::grid_group grid = cg::this_grid();
    volatile LAS unsigned* MISC = (volatile LAS unsigned*)(X.lds + LDS_MISC);
    if (X.tid < 16) MISC[X.tid] = 0u;
    __syncthreads();
    XcdBarrier bar; bar.bar = (unsigned*)(ws + WS_BAR); bar.x = 0; bar.st = nullptr;
    if (hi - lo > 1) {
        if (X.bx == 0) for (int i = X.tid; i < XCD_BAR_WORDS; i += 512) __hip_atomic_store((unsigned*)(ws + WS_BAR) + i, 0u, __ATOMIC_RELAXED, __HIP_MEMORY_SCOPE_AGENT);
        grid.sync();
        bar = xcd_barrier_post((unsigned*)(ws + WS_BAR), MISC); }
#define NREP(k) (1 + ((PROBE_DUP >> (k)) & 1))
#define PHASE(k, ...) if (lo <= (k) && (k) < hi) { __VA_ARGS__ if (NREP(k) == 2) { xcd_barrier(bar); __VA_ARGS__ } }
#define SEAM(k) do { if (lo <= (k) && (k) + 1 < hi) xcd_barrier(bar); } while (0)

    PHASE(0, { p0_prologue(X); }) SEAM(0);
    PHASE(1, { p_modulate(X, args.in[I_X], mod, 0, U, U8); }) SEAM(1);
    PHASE(2, { { pg8::Gemm g{U, W1IN, M_TOK, FIN_BF_TILES * 256, DM, DM}; pg8::StaticOrder S; S.init(M_TOK, FIN_BF_TILES * 256, X.G, X.bx); pg8::EpiSwiglu<false> E{ACT};
          pg8::gemm_phase<pg8::EpiSwiglu<false>, pg8::StaticOrder, true>(X.lds, g, S, E); }
        { pg8::Gemm g{(const bf16_t*)U8, (const bf16_t*)(ws + WS_W1IN8), M_TOK, (44 - FIN_BF_TILES) * 256, DM, DM}; pg8::StaticOrder S; S.init(M_TOK, (44 - FIN_BF_TILES) * 256, X.G, X.bx); pg8::EpiSwiglu<true> E{ACT};
          pg8::gemm_phase<pg8::EpiSwiglu<true>, pg8::StaticOrder, true, true>(X.lds, g, S, E); } }) SEAM(2);
    PHASE(3, { pg8::Gemm g{ACT, W1OUT, M_TOK, DM, DFF, DFF}; pg8::StaticOrder S; S.init(M_TOK, DM, X.G, X.bx); pg8::EpiResidT<false> E{args.in[I_X], R, mod + 2 * DM, 0.5f, nullptr, nullptr, nullptr};
        pg8::gemm_phase<pg8::EpiResidT<false>, pg8::StaticOrder, ALIGN2>(X.lds, g, S, E); }) SEAM(3);
    PHASE(4, { p_layernorm<false, true>(X, R, args.in[I_LN1G], args.in[I_LN1B], nullptr, STATS, mod, 3 * DM, U, U8); }) SEAM(4);
    PHASE(5, { { pg8::Gemm g{U, WMIX, M_TOK, 6144, DM, DM}; pg8::StaticOrder S; S.init(M_TOK, 6144, X.G, X.bx); pg8::EpiMix E{MIX, GATES};
          pg8::gemm_phase<pg8::EpiMix, pg8::StaticOrder, true>(X.lds, g, S, E); }
        { pg8::Gemm g{(const bf16_t*)U8, (const bf16_t*)(ws + WS_WG8), M_TOK, 4096, DM, DM}; pg8::StaticOrder S; S.init(M_TOK, 4096, X.G, X.bx); pg8::EpiGates8 E{GATES};
          pg8::gemm_phase<pg8::EpiGates8, pg8::StaticOrder, true, true>(X.lds, g, S, E); } }) SEAM(5);
    PHASE(6, {
        p_gla_chunk(X, U, WLR, MIX, DEC, UB, args.in[I_WA2], args.in[I_BAL]);
        LAS float* bt = (LAS float*)(X.lds + L_ABIAS);
        for (int i = X.tid; i < 16 * 320; i += 512) bt[i] = args.in[I_RELB][i] * LOG2E;
        __syncthreads();
        for (int uid = X.bx * 8 + X.wave; uid < 8192; uid += X.G * 8) { const int half = uid & 1, n = (uid >> 1) & 63, bh = uid >> 7; attn_unit(X, MIX, bh >> 4, bh & 15, n, half); }
    }) SEAM(6);
    PHASE(7, { p_gla_scan_elem(X, DEC, UB, ST); }) SEAM(7);
    PHASE(8, { p_gla_readout(X, MIX, ST, args.in[I_GNG]); }) SEAM(8);
    PHASE(9, { pg8::Gemm g{MIX + C_QA, WPA, M_TOK, DM, 1024, MIXP}; pg8::StaticOrder S; S.init(M_TOK, DM, X.G, X.bx); pg8::EpiGate<false> E{GATES, U, nullptr};
        pg8::gemm_phase<pg8::EpiGate<false>, pg8::StaticOrder, true>(X.lds, g, S, E); asm volatile("s_waitcnt vmcnt(0)" ::: "memory"); __syncthreads(); })
    PHASE(10, { pg8::Gemm g{MIX + C_RB, WPB, M_TOK, DM, 1024, MIXP}; pg8::StaticOrder S; S.init(M_TOK, DM, X.G, X.bx); pg8::EpiGate<true> E{GATES + 2048, U, MIX + C_MERGED};
        pg8::gemm_phase<pg8::EpiGate<true>, pg8::StaticOrder, true>(X.lds, g, S, E); }) SEAM(10);
    PHASE(11, { pg8::Gemm g{MIX + C_MERGED, WMO, M_TOK, DM, DM, MIXP}; pg8::StaticOrder S; S.init(M_TOK, DM, X.G, X.bx); pg8::EpiResidT<true> E{R, R, mod + 5 * DM, 1.0f, STATS, args.in[I_LN1G], args.in[I_LN1B]};
        pg8::gemm_phase<pg8::EpiResidT<true>, pg8::StaticOrder, ALIGN2>(X.lds, g, S, E); }) SEAM(11);
    PHASE(12, { p_layernorm<false, true>(X, R, args.in[I_LN2G], args.in[I_LN2B], nullptr, STATS, mod, 6 * DM, U, U8); }) SEAM(12);
    PHASE(13, { { pg8::Gemm g{U, W2IN, M_TOK, FIN_BF_TILES * 256, DM, DM}; pg8::StaticOrder S; S.init(M_TOK, FIN_BF_TILES * 256, X.G, X.bx); pg8::EpiSwiglu<false> E{ACT};
          pg8::gemm_phase<pg8::EpiSwiglu<false>, pg8::StaticOrder, true>(X.lds, g, S, E); }
        { pg8::Gemm g{(const bf16_t*)U8, (const bf16_t*)(ws + WS_W2IN8), M_TOK, (44 - FIN_BF_TILES) * 256, DM, DM}; pg8::StaticOrder S; S.init(M_TOK, (44 - FIN_BF_TILES) * 256, X.G, X.bx); pg8::EpiSwiglu<true> E{ACT};
          pg8::gemm_phase<pg8::EpiSwiglu<true>, pg8::StaticOrder, true, true>(X.lds, g, S, E); } }) SEAM(13);
    PHASE(14, { pg8::Gemm g{ACT, W2OUT, M_TOK, DM, DFF, DFF}; pg8::StaticOrder S; S.init(M_TOK, DM, X.G, X.bx); pg8::EpiResidT<true> E{R, R, mod + 8 * DM, 0.5f, STATS, args.in[I_LN2G], args.in[I_LN2B]};
        pg8::gemm_phase<pg8::EpiResidT<true>, pg8::StaticOrder, ALIGN2>(X.lds, g, S, E); }) SEAM(14);
    PHASE(15, { p_layernorm<true>(X, R, args.in[I_LN3G], args.in[I_LN3B], R, nullptr, nullptr, 0, nullptr); })
#undef PHASE
#undef SEAM
}

constexpr int N_PHASES = 16;

extern "C" void kernel_launch(void* const* d_in, const int* in_sizes, int n_in, void* d_out, int out_size, void* d_ws, size_t ws_size, hipStream_t stream) {
    static int grid = 0;
    if (grid == 0) {
        if (n_in != 22 || out_size != M_TOK * DM || ws_size < WS_END) { fprintf(stderr, "kernel_launch: unexpected shapes (n_in %d, out %d, ws %zu < %zu)\n", n_in, out_size, ws_size, (size_t)WS_END); grid = -1; return; }
        int dev = 0, cus = 0, per_cu = 0;
        (void)hipGetDevice(&dev); (void)hipDeviceGetAttribute(&cus, hipDeviceAttributeMultiprocessorCount, dev);
        if (hipFuncSetAttribute((const void*)fwd_megakernel, hipFuncAttributeMaxDynamicSharedMemorySize, LDS_BYTES) != hipSuccess) { fprintf(stderr, "kernel_launch: hipFuncSetAttribute failed\n"); grid = -1; return; }
        if (hipOccupancyMaxActiveBlocksPerMultiprocessor(&per_cu, (const void*)fwd_megakernel, 512, LDS_BYTES) != hipSuccess || per_cu < 1) { fprintf(stderr, "kernel_launch: occupancy query says %d\n", per_cu); per_cu = 1; }
        (void)hipGetLastError();
        grid = cus > 0 ? cus : 256;
    }
    if (grid < 0) return;
#if !MK_COOP
    if (hipMemsetAsync((char*)d_ws + WS_BAR, 0, BAR_BYTES, stream) != hipSuccess) { fprintf(stderr, "kernel_launch: memset of the barrier words failed\n"); return; }
#endif
    Args a{};
    for (int i = 0; i < 22; ++i) a.in[i] = (const float*)d_in[i];
    a.out = (float*)d_out; a.ws = (unsigned char*)d_ws;
#if MK_COOP
    a.ph_lo = 0; a.ph_hi = N_PHASES;
    void* kargs[] = {&a};
    hipError_t e = hipLaunchCooperativeKernel((const void*)fwd_megakernel, dim3(grid), dim3(512), kargs, LDS_BYTES, stream);
    if (e != hipSuccess) fprintf(stderr, "kernel_launch: cooperative launch failed: %s (grid %d)\n", hipGetErrorString(e), grid);
#else
    for (int ph = 0; ph < N_PHASES; ++ph) { a.ph_lo = ph; a.ph_hi = ph + 1; hipLaunchKernelGGL(fwd_megakernel, dim3(grid), dim3(512), LDS_BYTES, stream, a); }
#endif
}
```
